# Optimizing an MI355X kernel written in HIP

```python
import jax, jax.numpy as jnp
from jax import lax
import numpy as np

D_MODEL = 2048
BATCH = 1
SEQ = 8192
DEPTH = 1
DEC_BATCH = 16
DEC_SEQ = 64
PAST_LEN = 4096

CHUNK = 64
H_RET = 8
DK_RET = 128
DV_RET = 128
H_GDN = 8
DK_GDN = 128
DV_GDN = 128
CONV_W = 4
D_FF = 5632
ROPE_BASE = 10000.0
EPS = 1e-6

RET_QK = H_RET * DK_RET
RET_V = H_RET * DV_RET
GDN_QK = H_GDN * DK_GDN
GDN_V = H_GDN * DV_GDN
GDN_CONV_CH = 2 * GDN_QK + GDN_V
D_MIX = RET_V + GDN_V
IN_SIZES = [RET_QK, RET_QK, RET_V, RET_V, GDN_CONV_CH, GDN_V, H_GDN, H_GDN]
IN_SPLITS = [int(s) for s in np.cumsum(IN_SIZES)[:-1]]
N_IN = int(sum(IN_SIZES))

kernel_name = "hybrid_retention_gdn_macaron_step"


def _rmsnorm(x, g):
    xf = x.astype(jnp.float32)
    y = xf * lax.rsqrt(jnp.mean(xf * xf, axis=-1, keepdims=True) + EPS)
    return (y * g.astype(jnp.float32)).astype(x.dtype)


def _head_rmsnorm(o, g):
    return o * lax.rsqrt(jnp.mean(o * o, axis=-1, keepdims=True) + EPS) * g.astype(jnp.float32)


def _l2norm(x):
    return x * lax.rsqrt(jnp.sum(x * x, axis=-1, keepdims=True) + EPS)


def _swiglu(h, w_gate, w_up, w_down):
    return (jax.nn.silu(h @ w_gate) * (h @ w_up)) @ w_down


def _rotary(x, pos):
    half = x.shape[-1] // 2
    inv = ROPE_BASE ** (-jnp.arange(half, dtype=jnp.float32) / half)
    ang = pos[:, None] * inv[None, :]
    cos = jnp.cos(ang)[None, :, None, :]
    sin = jnp.sin(ang)[None, :, None, :]
    x1, x2 = x[..., :half], x[..., half:]
    return jnp.concatenate([x1 * cos - x2 * sin, x1 * sin + x2 * cos], axis=-1)


def _retention(q, k, v, s0, log_gamma):
    B, L, H, DK = q.shape
    DV = v.shape[-1]
    c = min(CHUNK, L)
    n = L // c
    qc = q.reshape(B, n, c, H, DK)
    kc = k.reshape(B, n, c, H, DK)
    vc = v.reshape(B, n, c, H, DV)
    t = jnp.arange(c, dtype=jnp.float32)
    diff = t[:, None] - t[None, :]
    causal = diff >= 0
    dmat = jnp.where(causal[None], jnp.exp(jnp.where(causal, diff, 0.0)[None] * log_gamma[:, None, None]), 0.0)
    scores = jnp.einsum('bnthd,bnshd->bnhts', qc, kc) * dmat
    o_intra = jnp.einsum('bnhts,bnshe->bnthe', scores, vc)
    q_dec = jnp.exp((t + 1.0)[:, None] * log_gamma[None, :])
    k_dec = jnp.exp((c - 1.0 - t)[:, None] * log_gamma[None, :])
    chunk_dec = jnp.exp(c * log_gamma)
    kv = jnp.einsum('bnshd,bnshe->bnhde', kc * k_dec[None, None, :, :, None], vc)

    def step(s, kv_i):
        return s * chunk_dec[None, :, None, None] + kv_i, s

    s_final, s_prev = lax.scan(step, s0, jnp.moveaxis(kv, 1, 0))
    s_prev = jnp.moveaxis(s_prev, 0, 1)
    o_inter = jnp.einsum('bnthd,bnhde->bnthe', qc * q_dec[None, None, :, :, None], s_prev)
    return (o_intra + o_inter).reshape(B, L, H, DV), s_final


def _gated_delta(q, k, v, g, beta, s0):
    B, L, H, DK = q.shape
    DV = v.shape[-1]
    c = min(CHUNK, L)
    n = L // c
    qc = q.reshape(B, n, c, H, DK).transpose(0, 1, 3, 2, 4)
    kc = k.reshape(B, n, c, H, DK).transpose(0, 1, 3, 2, 4)
    vc = v.reshape(B, n, c, H, DV).transpose(0, 1, 3, 2, 4)
    gc = jnp.cumsum(g.reshape(B, n, c, H).transpose(0, 1, 3, 2), axis=-1)
    bc = beta.reshape(B, n, c, H).transpose(0, 1, 3, 2)
    t = jnp.arange(c)
    tri = t[:, None] >= t[None, :]
    strict = t[:, None] > t[None, :]
    gdiff = gc[..., :, None] - gc[..., None, :]
    decay = jnp.where(tri, jnp.exp(jnp.where(tri, gdiff, 0.0)), 0.0)
    kk = jnp.einsum('bnhtd,bnhsd->bnhts', kc, kc)
    a_mat = jnp.where(strict, kk * decay * bc[..., :, None], 0.0)
    lhs = a_mat + jnp.eye(c, dtype=jnp.float32)
    w = lax.linalg.triangular_solve(lhs, kc * (bc * jnp.exp(gc))[..., None], left_side=True, lower=True, unit_diagonal=True)
    u = lax.linalg.triangular_solve(lhs, vc * bc[..., None], left_side=True, lower=True, unit_diagonal=True)
    qk = jnp.einsum('bnhtd,bnhsd->bnhts', qc, kc) * decay
    q_dec = qc * jnp.exp(gc)[..., None]
    k_dec = kc * jnp.exp(gc[..., -1:] - gc)[..., None]
    chunk_dec = jnp.exp(gc[..., -1])

    def step(s, inp):
        w_i, u_i, qk_i, q_i, kd_i, cd_i = inp
        delta = u_i - jnp.einsum('bhtd,bhde->bhte', w_i, s)
        o = jnp.einsum('bhtd,bhde->bhte', q_i, s) + jnp.einsum('bhts,bhse->bhte', qk_i, delta)
        s_new = s * cd_i[..., None, None] + jnp.einsum('bhtd,bhte->bhde', kd_i, delta)
        return s_new, o

    xs = tuple(jnp.moveaxis(a, 1, 0) for a in (w, u, qk, q_dec, k_dec, chunk_dec))
    s_final, o = lax.scan(step, s0, xs)
    o = o.transpose(1, 0, 3, 2, 4).reshape(B, L, H, DV)
    return o, s_final


def _mixer(h, s_ret, s_gdn, conv_buf, pos, w_in, ret_norm, conv_w, a_log, dt_bias, gdn_norm, w_out):
    B, L, _ = h.shape
    f32 = jnp.float32
    p = (h @ w_in).astype(f32)
    rq, rk, rv, rg, gqkv, gg, ga, gb = jnp.split(p, IN_SPLITS, axis=-1)
    log_gamma = jnp.log(1.0 - 2.0 ** (-5.0 - jnp.arange(H_RET, dtype=f32)))
    rq = _rotary(rq.reshape(B, L, H_RET, DK_RET), pos) * (DK_RET ** -0.5)
    rk = _rotary(rk.reshape(B, L, H_RET, DK_RET), pos)
    o_r, s_ret_new = _retention(rq, rk, rv.reshape(B, L, H_RET, DV_RET), s_ret.astype(f32), log_gamma)
    o_r = _head_rmsnorm(o_r, ret_norm.reshape(H_RET, DV_RET)) * jax.nn.silu(rg).reshape(B, L, H_RET, DV_RET)
    xpad = jnp.concatenate([conv_buf.astype(f32), gqkv], axis=1)
    conv_new = xpad[:, L:]
    cw = conv_w.astype(f32)
    gqkv = jax.nn.silu(sum(xpad[:, i:i + L] * cw[i] for i in range(CONV_W)))
    gq, gk, gv = jnp.split(gqkv, [GDN_QK, 2 * GDN_QK], axis=-1)
    gq = _l2norm(gq.reshape(B, L, H_GDN, DK_GDN)) * (DK_GDN ** -0.5)
    gk = _l2norm(gk.reshape(B, L, H_GDN, DK_GDN))
    gv = gv.reshape(B, L, H_GDN, DV_GDN)
    g_log = -jnp.exp(a_log.astype(f32)) * jax.nn.softplus(ga + dt_bias.astype(f32))
    beta = jax.nn.sigmoid(gb)
    o_g, s_gdn_new = _gated_delta(gq, gk, gv, g_log, beta, s_gdn.astype(f32))
    o_g = _head_rmsnorm(o_g, gdn_norm) * jax.nn.silu(gg).reshape(B, L, H_GDN, DV_GDN)
    o = jnp.concatenate([o_r.reshape(B, L, RET_V), o_g.reshape(B, L, GDN_V)], axis=-1).astype(h.dtype)
    return o @ w_out, s_ret_new.astype(s_ret.dtype), s_gdn_new.astype(s_gdn.dtype), conv_new.astype(conv_buf.dtype)


def _layer(x, s_ret, s_gdn, conv_buf, pos, lp):
    (ffn1_norm, ffn1_w_gate, ffn1_w_up, ffn1_w_down, mix_norm, w_in, ret_norm, gdn_conv,
     gdn_a_log, gdn_dt_bias, gdn_norm, w_out, ffn2_norm, ffn2_w_gate, ffn2_w_up, ffn2_w_down) = lp
    x = x + 0.5 * _swiglu(_rmsnorm(x, ffn1_norm), ffn1_w_gate, ffn1_w_up, ffn1_w_down)
    m, s_ret, s_gdn, conv_buf = _mixer(_rmsnorm(x, mix_norm), s_ret, s_gdn, conv_buf, pos, w_in, ret_norm,
                                       gdn_conv, gdn_a_log, gdn_dt_bias, gdn_norm, w_out)
    x = x + m
    x = x + 0.5 * _swiglu(_rmsnorm(x, ffn2_norm), ffn2_w_gate, ffn2_w_up, ffn2_w_down)
    return x, s_ret, s_gdn, conv_buf


def setup_inputs(seed: int = 0) -> dict:
    key = jax.random.key(seed)
    ks = jax.random.split(key, 24)
    f32 = jnp.float32

    def nrm(k, shape, scale):
        return jax.random.normal(k, shape, f32) * scale

    def gain(k, shape):
        return 1.0 + 0.02 * jax.random.normal(k, shape, f32)

    dt = jnp.exp(jax.random.uniform(ks[14], (DEPTH, H_GDN), f32, np.log(1e-3), np.log(1e-1)))
    return {
        "x_prompt": nrm(ks[0], (BATCH, SEQ, D_MODEL), 1.0),
        "x_sample": nrm(ks[1], (DEC_BATCH, DEC_SEQ, D_MODEL), 1.0),
        "state_ret": nrm(ks[2], (DEPTH, DEC_BATCH, H_RET, DK_RET, DV_RET), 0.1),
        "state_gdn": nrm(ks[3], (DEPTH, DEC_BATCH, H_GDN, DK_GDN, DV_GDN), 0.1),
        "state_conv": nrm(ks[4], (DEPTH, DEC_BATCH, CONV_W - 1, GDN_CONV_CH), 1.0),
        "ffn1_norm": gain(ks[5], (DEPTH, D_MODEL)),
        "ffn1_w_gate": nrm(ks[6], (DEPTH, D_MODEL, D_FF), D_MODEL ** -0.5),
        "ffn1_w_up": nrm(ks[7], (DEPTH, D_MODEL, D_FF), D_MODEL ** -0.5),
        "ffn1_w_down": nrm(ks[8], (DEPTH, D_FF, D_MODEL), D_FF ** -0.5),
        "mix_norm": gain(ks[9], (DEPTH, D_MODEL)),
        "w_in": nrm(ks[10], (DEPTH, D_MODEL, N_IN), D_MODEL ** -0.5),
        "ret_norm": gain(ks[11], (DEPTH, RET_V)),
        "gdn_conv": nrm(ks[12], (DEPTH, CONV_W, GDN_CONV_CH), CONV_W ** -0.5),
        "gdn_a_log": jnp.log(jax.random.uniform(ks[13], (DEPTH, H_GDN), f32, 1.0, 16.0)),
        "gdn_dt_bias": dt + jnp.log(-jnp.expm1(-dt)),
        "gdn_norm": gain(ks[15], (DEPTH, DV_GDN)),
        "w_out": nrm(ks[16], (DEPTH, D_MIX, D_MODEL), D_MIX ** -0.5),
        "ffn2_norm": gain(ks[17], (DEPTH, D_MODEL)),
        "ffn2_w_gate": nrm(ks[18], (DEPTH, D_MODEL, D_FF), D_MODEL ** -0.5),
        "ffn2_w_up": nrm(ks[19], (DEPTH, D_MODEL, D_FF), D_MODEL ** -0.5),
        "ffn2_w_down": nrm(ks[20], (DEPTH, D_FF, D_MODEL), D_FF ** -0.5),
        "final_norm": gain(ks[21], (D_MODEL,)),
    }


def reference(x_prompt, x_sample, state_ret, state_gdn, state_conv, ffn1_norm, ffn1_w_gate, ffn1_w_up,
              ffn1_w_down, mix_norm, w_in, ret_norm, gdn_conv, gdn_a_log, gdn_dt_bias, gdn_norm, w_out,
              ffn2_norm, ffn2_w_gate, ffn2_w_up, ffn2_w_down, final_norm):
    Bp, Lp, _ = x_prompt.shape
    Ls = x_sample.shape[1]
    pos_p = jnp.arange(Lp, dtype=jnp.float32)
    pos_s = PAST_LEN + jnp.arange(Ls, dtype=jnp.float32)
    yp, ys = x_prompt, x_sample
    rp, gp, cp, rs, gs, cs = [], [], [], [], [], []
    for l in range(DEPTH):
        lp = (ffn1_norm[l], ffn1_w_gate[l], ffn1_w_up[l], ffn1_w_down[l], mix_norm[l], w_in[l], ret_norm[l],
              gdn_conv[l], gdn_a_log[l], gdn_dt_bias[l], gdn_norm[l], w_out[l], ffn2_norm[l], ffn2_w_gate[l],
              ffn2_w_up[l], ffn2_w_down[l])
        z_ret = jnp.zeros((Bp, H_RET, DK_RET, DV_RET), state_ret.dtype)
        z_gdn = jnp.zeros((Bp, H_GDN, DK_GDN, DV_GDN), state_gdn.dtype)
        z_conv = jnp.zeros((Bp, CONV_W - 1, GDN_CONV_CH), state_conv.dtype)
        yp, a, b, c = _layer(yp, z_ret, z_gdn, z_conv, pos_p, lp)
        ys, d, e, f = _layer(ys, state_ret[l], state_gdn[l], state_conv[l], pos_s, lp)
        rp.append(a); gp.append(b); cp.append(c)
        rs.append(d); gs.append(e); cs.append(f)
    y_prompt = _rmsnorm(yp, final_norm)
    y_sample = _rmsnorm(ys, final_norm)
    return (y_prompt, y_sample, jnp.stack(rp), jnp.stack(gp), jnp.stack(cp), jnp.stack(rs), jnp.stack(gs), jnp.stack(cs))
```

```cpp
#include <hip/hip_runtime.h>
#include <cstdio>
#include <cstdint>
namespace pg8 {
#define PG8_LAS __attribute__((address_space(3)))
typedef unsigned short bf16_t;
typedef short bf16x8 __attribute__((ext_vector_type(8)));
typedef float f32x4 __attribute__((ext_vector_type(4)));
typedef unsigned u32x4 __attribute__((ext_vector_type(4)));
constexpr int BM = 256, BK = 64, HALF = 128, HTB = HALF * BK * 2  , STAGE_BYTES = 8 * HTB, NXCD = 8, WGM = 4;

__host__ __device__ __forceinline__ int lds_byte(int r, int c) { const int st = (r >> 4) * 2 + (c >> 5), rr = r & 15, cc = c & 31, ob = rr * 64 + cc * 2; return st * 1024 + (ob ^ (((ob >> 9) & 1) << 5)); }
__host__ __device__ __forceinline__ void stage_rc(int b, int& R, int& C) { const int st = b / 1024, sb = b % 1024, swz = sb ^ (((sb >> 9) & 1) << 5); R = (st >> 1) * 16 + swz / 64; C = (st & 1) * 32 + (swz % 64) / 2; }
__host__ __device__ __forceinline__ int perm32(int rho) { const int n = rho >> 4, i = rho & 15; return 8 * (i >> 2) + 4 * n + (i & 3); }

struct Unit { int pm, pn, k0, nt, part; };
struct Gemm { const bf16_t* A; const bf16_t* Bt; int M, N, K; };

struct StaticOrder {
    int nM, nN, nwg, G, c;
    __host__ __device__ void init(int M, int N, int G_, int c_) { nM = M / BM; nN = N / BM; nwg = nM * nN; G = G_; c = c_; }
    __host__ __device__ __forceinline__ bool next(int i, Unit& u) const { return tile((long)i * G + c, u); }
    __host__ __device__ __forceinline__ bool tile(long L, Unit& u) const {
        u.k0 = 0; u.nt = 0; u.part = 0;
        if (L >= nwg) return false;
        int wgid = (int)L; { const int q = nwg / NXCD, r = nwg % NXCD, xcd = wgid % NXCD, off = wgid / NXCD; wgid = (xcd < r ? xcd * (q + 1) : r * (q + 1) + (xcd - r) * q) + off; }
        const int nig = WGM * nN, gid = wgid / nig, fm = gid * WGM, gsz = (nM - fm) < WGM ? (nM - fm) : WGM;
        u.pm = fm + ((wgid % nig) % gsz); u.pn = (wgid % nig) / gsz; return true;
    }
    __device__ __forceinline__ void a_ready(const Unit&) const {}
    __device__ __forceinline__ void done(const Unit&) const {}
};

__device__ __forceinline__ unsigned cvt_pk_bf16(float lo, float hi) { unsigned r; asm volatile("v_cvt_pk_bf16_f32 %0, %1, %2" : "=v"(r) : "v"(lo), "v"(hi)); return r; }
typedef float f32x2 __attribute__((ext_vector_type(2)));
template <class Epi, class Sched, bool ALIGN_EPI = false, bool SP2 = false>
__device__ __forceinline__ void gemm_phase(PG8_LAS unsigned char* lds, const Gemm g, const Sched& S, const Epi& E, const int tid_in) {
    const int tid = tid_in, wid = __builtin_amdgcn_readfirstlane(tid >> 6), lane = tid & 63, wr = wid >> 2, wc = wid & 3, fr = lane & 15, fq = lane >> 4;
    const int K = g.K, nt = K / BK;
    unsigned voffA[2], voffB[2];
#pragma unroll
    for (int i = 0; i < 2; ++i) { int R, C; stage_rc(tid * 16 + i * 8192, R, C); const int Rb = Epi::PERM ? ((R & ~31) + perm32(R & 31)) : R;
        voffA[i] = (unsigned)(R * K + C) * 2u; voffB[i] = (unsigned)(Rb * K + C) * 2u; }
    const size_t kstep = (size_t)(BK * 2);
    const size_t hstep = (size_t)HALF * K * 2;
    const size_t tstep = 2 * hstep;
    const unsigned ldsw = (unsigned)wid * 1024u;
    const int aoff = lds_byte(wr * 64 + fr, fq * 8), boff = lds_byte(wc * 32 + fr, fq * 8);
#define PG8_SA(b, h) (((b) * 2 + (h)) * HTB)
#define PG8_SB(b, h) ((4 + (b) * 2 + (h)) * HTB)
#define PG8_STAGE(bufoff, gbase, voff) do { _Pragma("unroll") for (int _i = 0; _i < 2; ++_i) \
        __builtin_amdgcn_global_load_lds((const unsigned*)((const char*)(gbase) + (voff)[_i]), (PG8_LAS unsigned*)(lds + (bufoff) + ldsw + _i * 8192), 16, 0, 0); } while (0)
#define PG8_LDA(dst, b, h) do { _Pragma("unroll") for (int m = 0; m < 4; ++m) _Pragma("unroll") for (int k = 0; k < 2; ++k) dst[m][k] = *(const PG8_LAS bf16x8*)(lds + PG8_SA(b, h) + aoff + m * 2048 + k * 1024); } while (0)
#define PG8_LDB(dst, b, h) do { _Pragma("unroll") for (int n = 0; n < 2; ++n) _Pragma("unroll") for (int k = 0; k < 2; ++k) dst[n][k] = *(const PG8_LAS bf16x8*)(lds + PG8_SB(b, h) + boff + n * 2048 + k * 1024); } while (0)
#define PG8_MMA(ai, bj, At, Bt) do { __builtin_amdgcn_s_setprio(1); _Pragma("unroll") for (int m = 0; m < 4; ++m) _Pragma("unroll") for (int n = 0; n < 2; ++n) _Pragma("unroll") for (int k = 0; k < 2; ++k) \
        acc[ai][bj][m][n] = __builtin_amdgcn_mfma_f32_16x16x32_bf16(Bt[n][k], At[m][k], acc[ai][bj][m][n], 0, 0, 0); __builtin_amdgcn_s_setprio(0); } while (0)
#define PG8_WAIT_V(n) asm volatile("s_waitcnt vmcnt(" #n ")" ::: "memory")
#define PG8_WAIT_L(n) asm volatile("s_waitcnt lgkmcnt(" #n ")" ::: "memory")
#define PG8_BAR __builtin_amdgcn_s_barrier()
#define PG8_SCHED __builtin_amdgcn_sched_barrier(0)
    Unit cur, nxt; int ui = 0;
    if (!S.next(0, cur)) return;
    f32x4 acc[2][2][4][2];
#pragma unroll
    for (int a = 0; a < 2; ++a)
#pragma unroll
        for (int b = 0; b < 2; ++b)
#pragma unroll
            for (int m = 0; m < 4; ++m)
#pragma unroll
                for (int n = 0; n < 2; ++n) acc[a][b][m][n] = (f32x4){0.f, 0.f, 0.f, 0.f};
    bf16x8 At[4][2], B0[2][2], B1[2][2];
    const char* cA = (const char*)g.A + (size_t)cur.pm * tstep + (size_t)cur.k0 * kstep; const char* cB = (const char*)g.Bt + (size_t)cur.pn * tstep + (size_t)cur.k0 * kstep;
    S.a_ready(cur);
    if constexpr (SP2) {
        PG8_STAGE(PG8_SB(0, 0), cB, voffB); PG8_STAGE(PG8_SB(0, 1), cB + hstep, voffB); PG8_STAGE(PG8_SA(0, 0), cA, voffA); PG8_STAGE(PG8_SA(0, 1), cA + hstep, voffA);
        if (wr == 1) PG8_BAR;
        PG8_WAIT_V(2); PG8_BAR;
        PG8_STAGE(PG8_SB(1, 0), cB + kstep, voffB); PG8_STAGE(PG8_SA(1, 0), cA + kstep, voffA); PG8_STAGE(PG8_SB(1, 1), cB + hstep + kstep, voffB);
        PG8_WAIT_V(6); PG8_BAR;
    } else {
        PG8_STAGE(PG8_SB(0, 0), cB, voffB); PG8_STAGE(PG8_SA(0, 0), cA, voffA); PG8_STAGE(PG8_SB(0, 1), cB + hstep, voffB); PG8_STAGE(PG8_SA(0, 1), cA + hstep, voffA);
        if (wr == 1) PG8_BAR;
        PG8_WAIT_V(4); PG8_BAR;
        PG8_STAGE(PG8_SB(1, 0), cB + kstep, voffB); PG8_STAGE(PG8_SA(1, 0), cA + kstep, voffA); PG8_STAGE(PG8_SB(1, 1), cB + hstep + kstep, voffB);
        PG8_WAIT_V(6); PG8_BAR;
    }
    for (;;) {
        const bool has_next = S.next(ui + 1, nxt);
        const char* nA = has_next ? (const char*)g.A + (size_t)nxt.pm * tstep + (size_t)nxt.k0 * kstep : cA; const char* nB = has_next ? (const char*)g.Bt + (size_t)nxt.pn * tstep + (size_t)nxt.k0 * kstep : cB;
        const int cnt = cur.nt ? cur.nt : nt;
        for (int t = 0; t < cnt; t += 2) {
            const bool last = (t == cnt - 2);
            const char* a1 = cA + (size_t)(t + 1) * kstep;
            const char* a2 = last ? nA : cA + (size_t)(t + 2) * kstep; const char* b2 = last ? nB : cB + (size_t)(t + 2) * kstep;
            const char* a3 = a2 + kstep; const char* b3 = b2 + kstep;
            if (last && has_next) S.a_ready(nxt);
            if constexpr (SP2) {
            PG8_LDB(B0, 0, 0); PG8_LDB(B1, 0, 1); PG8_SCHED; PG8_LDA(At, 0, 0); PG8_STAGE(PG8_SA(1, 1), a1 + hstep, voffA);
            PG8_WAIT_V(8); PG8_WAIT_L(0); PG8_BAR; PG8_MMA(0, 0, At, B0); PG8_MMA(0, 1, At, B1); PG8_BAR; PG8_SCHED;
            PG8_LDA(At, 0, 1); PG8_STAGE(PG8_SB(0, 0), b2, voffB); PG8_STAGE(PG8_SB(0, 1), b2 + hstep, voffB); PG8_STAGE(PG8_SA(0, 0), a2, voffA);
            PG8_WAIT_V(8); PG8_WAIT_L(0); PG8_BAR; PG8_MMA(1, 0, At, B0); PG8_MMA(1, 1, At, B1); PG8_BAR; PG8_SCHED;
            PG8_LDB(B0, 1, 0); PG8_LDB(B1, 1, 1); PG8_SCHED; PG8_LDA(At, 1, 0); PG8_STAGE(PG8_SA(0, 1), a2 + hstep, voffA);
            PG8_WAIT_V(8); PG8_WAIT_L(0); PG8_BAR; PG8_MMA(0, 0, At, B0); PG8_MMA(0, 1, At, B1); PG8_BAR; PG8_SCHED;
            PG8_LDA(At, 1, 1); PG8_STAGE(PG8_SB(1, 0), b3, voffB); PG8_STAGE(PG8_SB(1, 1), b3 + hstep, voffB); PG8_STAGE(PG8_SA(1, 0), a3, voffA);
            PG8_WAIT_V(8); PG8_WAIT_L(0); PG8_BAR; PG8_MMA(1, 0, At, B0); PG8_MMA(1, 1, At, B1); PG8_BAR; PG8_SCHED;
            } else {
            PG8_LDB(B0, 0, 0); PG8_SCHED; PG8_LDA(At, 0, 0); PG8_STAGE(PG8_SA(1, 1), a1 + hstep, voffA);
            PG8_WAIT_L(8); PG8_BAR; PG8_WAIT_L(0); PG8_MMA(0, 0, At, B0); PG8_BAR; PG8_SCHED;
            PG8_LDB(B1, 0, 1); PG8_STAGE(PG8_SB(0, 0), b2, voffB);
            PG8_BAR; PG8_WAIT_L(0); PG8_MMA(0, 1, At, B1); PG8_BAR;
            PG8_LDA(At, 0, 1); PG8_STAGE(PG8_SA(0, 0), a2, voffA);
            PG8_BAR; PG8_WAIT_L(0); PG8_MMA(1, 0, At, B0); PG8_BAR; PG8_SCHED;
            PG8_STAGE(PG8_SB(0, 1), b2 + hstep, voffB);
            PG8_WAIT_V(6); PG8_BAR; PG8_MMA(1, 1, At, B1); PG8_BAR;
            PG8_LDB(B0, 1, 0); PG8_SCHED; PG8_LDA(At, 1, 0); PG8_STAGE(PG8_SA(0, 1), a2 + hstep, voffA);
            PG8_WAIT_L(8); PG8_BAR; PG8_WAIT_L(0); PG8_MMA(0, 0, At, B0); PG8_BAR; PG8_SCHED;
            PG8_LDB(B1, 1, 1); PG8_STAGE(PG8_SB(1, 0), b3, voffB);
            PG8_BAR; PG8_WAIT_L(0); PG8_MMA(0, 1, At, B1); PG8_BAR;
            PG8_LDA(At, 1, 1); PG8_STAGE(PG8_SA(1, 0), a3, voffA);
            PG8_BAR; PG8_WAIT_L(0); PG8_MMA(1, 0, At, B0); PG8_BAR; PG8_SCHED;
            PG8_STAGE(PG8_SB(1, 1), b3 + hstep, voffB);
            PG8_WAIT_V(6); PG8_BAR; PG8_MMA(1, 1, At, B1); PG8_BAR;
            }
        }
        if constexpr (ALIGN_EPI) { if (wr == 0) PG8_BAR; }
        if constexpr (!Epi::AFTER_DRAIN) { E(acc, cur, wr, wc, fr, fq); S.done(cur); }
        if (!has_next) break;
#pragma unroll
        for (int a = 0; a < 2; ++a)
#pragma unroll
            for (int b = 0; b < 2; ++b)
#pragma unroll
                for (int m = 0; m < 4; ++m)
#pragma unroll
                    for (int n = 0; n < 2; ++n) acc[a][b][m][n] = (f32x4){0.f, 0.f, 0.f, 0.f};
        cur = nxt; cA = nA; cB = nB; ++ui;
        if constexpr (ALIGN_EPI) { if (wr == 1) PG8_BAR; }
    }
    PG8_WAIT_V(0);
    if constexpr (!ALIGN_EPI) { if (wr == 0) PG8_BAR; }
    PG8_BAR;
    if constexpr (Epi::AFTER_DRAIN) { E.fused(acc, cur, wr, wc, fr, fq, lds, wid, lane); S.done(cur); }
#undef PG8_SA
#undef PG8_SB
#undef PG8_STAGE
#undef PG8_LDA
#undef PG8_LDB
#undef PG8_MMA
#undef PG8_WAIT_V
#undef PG8_WAIT_L
#undef PG8_BAR
#undef PG8_SCHED
}
}

#define GAS __attribute__((address_space(1)))
#define LAS __attribute__((address_space(3)))
typedef unsigned short bf16;
typedef unsigned u32x4 __attribute__((ext_vector_type(4)));
typedef unsigned u32x2 __attribute__((ext_vector_type(2)));
typedef float f32x4 __attribute__((ext_vector_type(4)));
typedef short bf16x8 __attribute__((ext_vector_type(8)));

constexpr int NTHR = 512, NWAVES = 8;
constexpr int DM = 2048, DFF = 5632, MP = 8192, MS = 1024, MT = MP + MS;
constexpr int NIN = 8208, NINP = 8448;
constexpr int NCH = 144;
constexpr int NITEM = 8 * NCH;
constexpr float EPS = 1e-6f;
constexpr int PW = 6144;
constexpr int LDS_BYTES = 147456;

constexpr size_t O_Y = 0;
constexpr size_t O_RETP = (size_t)MT * DM;
constexpr size_t O_GDNP = O_RETP + 8 * 16384;
constexpr size_t O_CONVP = O_GDNP + 8 * 16384;
constexpr size_t O_RETS = O_CONVP + 3 * 3072;
constexpr size_t O_GDNS = O_RETS + (size_t)16 * 8 * 16384;
constexpr size_t O_CONVS = O_GDNS + (size_t)16 * 8 * 16384;
constexpr size_t O_END = O_CONVS + (size_t)16 * 3 * 3072;

constexpr size_t SSQ_BYTES = (size_t)MT * 32 * 4;
constexpr size_t WS_SSQ0 = 0, WS_SSQ1 = WS_SSQ0 + SSQ_BYTES, WS_SSQ2 = WS_SSQ1 + SSQ_BYTES, WS_SSQ3 = WS_SSQ2 + SSQ_BYTES;
constexpr size_t WS_GAGB = WS_SSQ3 + SSQ_BYTES;
constexpr size_t WS_CDG = WS_GAGB + (size_t)MT * 16 * 4;
constexpr int XCD_BAR_WORDS_C = 3456;
constexpr size_t WS_BAR = 5767168;
constexpr size_t WS_R1 = 6u << 20;
static_assert(WS_CDG + NITEM * 4 <= WS_BAR && XCD_BAR_WORDS_C * 4 <= 16384 && WS_BAR + 16384 + 256 <= (6u << 20), "map");

constexpr size_t SZ_WGU = (size_t)2 * DFF * DM * 2, SZ_WD = (size_t)DM * DFF * 2, SZ_WIN = (size_t)NINP * DM * 2, SZ_WOUT = (size_t)DM * DM * 2;
constexpr size_t WS_WGU1 = WS_R1, WS_WD1 = WS_WGU1 + SZ_WGU, WS_WIN = WS_WD1 + SZ_WD, WS_WOUT = WS_WIN + SZ_WIN;
constexpr size_t SZ_ACT16 = (size_t)MT * DM * 2;
constexpr size_t WS_X1B = WS_WGU1;
static_assert(SZ_ACT16 <= SZ_WGU, "overlay");
constexpr size_t WS_R2 = WS_WOUT + SZ_WOUT;
constexpr size_t SZ_P = (size_t)MT * PW * 2;
constexpr size_t WS_P = WS_R2, WS_GATES = WS_P + SZ_P;
constexpr size_t WS_ACT = WS_R2, WS_XB0 = WS_ACT + (size_t)MT * DFF * 2;
static_assert(WS_XB0 + SZ_ACT16 <= WS_GATES + SZ_ACT16, "overlay");
constexpr size_t FR16 = 16384, FR8 = 8192;
constexpr size_t WS_SP = WS_R2;
constexpr size_t WS_DL = WS_SP + (size_t)2 * NITEM * 32768;
static_assert(WS_DL + (size_t)NITEM * FR16 <= WS_GATES, "overlay");
constexpr size_t WS_R3 = WS_GATES + SZ_ACT16;
constexpr size_t WS_NW = WS_R3, WS_KDG = WS_NW + NITEM * FR16, WS_QDG = WS_KDG + NITEM * FR16, WS_UG = WS_QDG + NITEM * FR16, WS_QKG = WS_UG + NITEM * FR16;
constexpr size_t WS_KDR = WS_QKG + NITEM * FR8, WS_QDR = WS_KDR + NITEM * FR16, WS_VR = WS_QDR + NITEM * FR16, WS_SCR = WS_VR + NITEM * FR16;
constexpr size_t WS_R3END = WS_SCR + NITEM * FR8;
constexpr size_t WS_X2B = WS_R3;
constexpr size_t WS_WGU2 = WS_WGU1;
constexpr size_t WS_WD2 = WS_R3END;
constexpr size_t WS_O = WS_WD1;
static_assert(WS_O + SZ_ACT16 <= WS_WOUT, "overlay");
constexpr size_t WS_SLAB = WS_R3 + (40u << 20);
static_assert(WS_SLAB + (size_t)256 * 65536 * 4 <= WS_R3END, "map");
constexpr size_t WS_END = WS_WD2 + SZ_WD;
constexpr size_t WS_QCTR = WS_BAR + 16384;

struct Args {
    const float* in[22];
    float* out; unsigned char* ws;
    int ph_lo, ph_hi;
};
enum { I_XP = 0, I_XS, I_SRET, I_SGDN, I_SCONV, I_F1N, I_F1G, I_F1U, I_F1D, I_MIXN, I_WIN, I_RETN, I_CONVW, I_ALOG, I_DTB, I_GDNN, I_WOUT, I_F2N, I_F2G, I_F2U, I_F2D, I_FINN };

typedef float f32x2 __attribute__((ext_vector_type(2)));
typedef __bf16 bf16x2v __attribute__((ext_vector_type(2)));
__device__ __forceinline__ unsigned pk2(float lo, float hi) { const f32x2 v = {lo, hi}; return __builtin_bit_cast(unsigned, __builtin_convertvector(v, bf16x2v)); }
__device__ __forceinline__ unsigned f2bf(float f) { return pk2(f, 0.f) & 0xffffu; }
__device__ __forceinline__ float bf2f(unsigned short b) { return __builtin_bit_cast(float, (unsigned)b << 16); }
__device__ __forceinline__ float silu_f(float g) { return g * __builtin_amdgcn_rcpf(1.f + __expf(-g)); }
__device__ __forceinline__ float wave_sum(float v) {
#pragma unroll
    for (int o = 1; o < 64; o <<= 1) v += __shfl_xor(v, o);
    return v;
}
__device__ __forceinline__ float row_rinv(const float* ssq, int row, int fq) {
    const f32x4* p = (const f32x4*)(ssq + (size_t)row * 32 + fq * 8);
    const f32x4 a = p[0], b = p[1];
    float s = ((a[0] + a[1]) + (a[2] + a[3])) + ((b[0] + b[1]) + (b[2] + b[3]));
    s += __shfl_xor(s, 16); s += __shfl_xor(s, 32);
    return rsqrtf(s * (1.f / DM) + EPS);
}

__device__ __forceinline__ int fresh_lane() { int l = __builtin_amdgcn_mbcnt_hi(~0u, __builtin_amdgcn_mbcnt_lo(~0u, 0u)); asm volatile("" : "+v"(l)); return l; }
#define REFRESH(F) do { (F).lane = fresh_lane(); (F).tid = (F).wave * 64 + (F).lane; } while (0)
using pg8::Unit;
struct EpiSwiglu {
    static constexpr bool PERM = true, AFTER_DRAIN = false;
    bf16* O; const float* ssq;
    __device__ __forceinline__ void operator()(const f32x4 (&acc)[2][2][4][2], const Unit& u, int wr, int wc, int fr, int fq) const {
        const int row0 = u.pm * 256 + wr * 64 + fr, col0 = u.pn * 128 + wc * 32 + 8 * fq;
        float rr[2][4];
#pragma unroll
        for (int ai = 0; ai < 2; ++ai)
#pragma unroll
            for (int m = 0; m < 4; ++m) rr[ai][m] = row_rinv(ssq, row0 + ai * 128 + m * 16, fq);
#pragma unroll
        for (int ai = 0; ai < 2; ++ai)
#pragma unroll
            for (int m = 0; m < 4; ++m) {
                const int row = row0 + ai * 128 + m * 16; const float r = rr[ai][m];
                float h[8];
#pragma unroll
                for (int n = 0; n < 2; ++n)
#pragma unroll
                    for (int k = 0; k < 4; ++k) { const float g = acc[ai][0][m][n][k] * r, up = acc[ai][1][m][n][k] * r; h[n * 4 + k] = silu_f(g) * up; }
                u32x4 w; w.x = pg8::cvt_pk_bf16(h[0], h[1]); w.y = pg8::cvt_pk_bf16(h[2], h[3]); w.z = pg8::cvt_pk_bf16(h[4], h[5]); w.w = pg8::cvt_pk_bf16(h[6], h[7]);
                *(u32x4*)(O + (size_t)row * DFF + col0) = w;
            }
    }
};
struct SplitOrder : pg8::StaticOrder {
    int ntq; bool split;
    __device__ __forceinline__ void init2(int M, int N, int K, int G_, int c_) { init(M, N, G_, c_); ntq = K / 64 / 4; split = (nwg > G) && (4 * (nwg - G) <= G) && (ntq >= 4) && !(ntq & 1) && (ntq * 4 * 64 == K); }
    __device__ __forceinline__ bool next(int i, Unit& u) const {
        if (!split) return pg8::StaticOrder::next(i, u);
        if (i == 0) return tile(c, u);
        if (i == 1 && (c >> 2) < nwg - G) { tile(G + (c >> 2), u); u.k0 = (c & 3) * ntq; u.nt = ntq; u.part = 1 + c; return true; }
        return false;
    }
};
struct EpiResid {
    static constexpr bool PERM = false, AFTER_DRAIN = false;
    const float* resp; const float* ress; float* out; bf16* outb; float* ssq; float scale; float* slab;
    __device__ __forceinline__ void operator()(const f32x4 (&acc)[2][2][4][2], const Unit& u, int wr, int wc, int fr, int fq) const {
        if (u.part) {
            float* sb = slab + (size_t)(u.part - 1) * 65536 + (wr * 64 + fr) * 256 + wc * 32 + 4 * fq;
#pragma unroll
            for (int ai = 0; ai < 2; ++ai)
#pragma unroll
                for (int m = 0; m < 4; ++m)
#pragma unroll
                    for (int bj = 0; bj < 2; ++bj)
#pragma unroll
                        for (int n = 0; n < 2; ++n) *(f32x4*)(sb + (ai * 128 + m * 16) * 256 + bj * 128 + n * 16) = acc[ai][bj][m][n];
            return;
        }
        const int col0 = u.pn * 256 + wc * 32 + 4 * fq;
        f32x4 res[2][2][2], resn[2][2][2];
#define RES_LOAD(dst, am_) do { const int ai_ = (am_) >> 1, m0_ = ((am_) & 1) * 2; \
            _Pragma("unroll") for (int mm = 0; mm < 2; ++mm) { const int row_ = u.pm * 256 + ai_ * 128 + wr * 64 + (m0_ + mm) * 16 + fr; \
                const float* rb_ = (row_ < MP) ? resp + (size_t)row_ * DM : ress + (size_t)(row_ - MP) * DM; \
                _Pragma("unroll") for (int bj = 0; bj < 2; ++bj) _Pragma("unroll") for (int n = 0; n < 2; ++n) dst[mm][bj][n] = *(const f32x4*)(rb_ + col0 + bj * 128 + n * 16); } } while (0)
        RES_LOAD(res, 0);
#pragma unroll
        for (int am = 0; am < 4; ++am) {
            const int ai = am >> 1, m0 = (am & 1) * 2;
            if (am < 3) RES_LOAD(resn, am + 1);
#pragma unroll
            for (int mm = 0; mm < 2; ++mm) {
                const int m = m0 + mm;
                const int row = u.pm * 256 + ai * 128 + wr * 64 + m * 16 + fr;
                float ss = 0.f;
#pragma unroll
                for (int bj = 0; bj < 2; ++bj)
#pragma unroll
                    for (int n = 0; n < 2; ++n) {
                        const int col = col0 + bj * 128 + n * 16;
                        const f32x4 v = res[mm][bj][n] + acc[ai][bj][m][n] * scale;
                        *(f32x4*)(out + (size_t)row * DM + col) = v;
                        ss += (v[0] * v[0] + v[1] * v[1]) + (v[2] * v[2] + v[3] * v[3]);
                        if (outb) { u32x2 w; w.x = pg8::cvt_pk_bf16(v[0], v[1]); w.y = pg8::cvt_pk_bf16(v[2], v[3]); *(u32x2*)(outb + (size_t)row * DM + col) = w; }
                    }
                ss += __shfl_xor(ss, 16); ss += __shfl_xor(ss, 32);
                if (fq == 0) ssq[(size_t)row * 32 + u.pn * 4 + wc] = ss;
            }
#pragma unroll
            for (int mm = 0; mm < 2; ++mm)
#pragma unroll
                for (int bj = 0; bj < 2; ++bj)
#pragma unroll
                    for (int n = 0; n < 2; ++n) res[mm][bj][n] = resn[mm][bj][n];
        }
#undef RES_LOAD
    }
};
struct EpiInProj {
    static constexpr bool PERM = true, AFTER_DRAIN = false;
    bf16* P; bf16* GATES; float* GAGB; const float* ssq; float* convp; float* convs;
    __device__ __forceinline__ void operator()(const f32x4 (&acc)[2][2][4][2], const Unit& u, int wr, int wc, int fr, int fq) const {
        const int pn = u.pn;
        const bool gate = (pn >= 12 && pn < 16) || (pn >= 28 && pn < 32);
        const bool convt = (pn >= 16 && pn < 28);
        float rr[2][4];
#pragma unroll
        for (int ai = 0; ai < 2; ++ai)
#pragma unroll
            for (int m = 0; m < 4; ++m) rr[ai][m] = row_rinv(ssq, u.pm * 256 + ai * 128 + wr * 64 + m * 16 + fr, fq);
#pragma unroll
        for (int ai = 0; ai < 2; ++ai)
#pragma unroll
            for (int m = 0; m < 4; ++m) {
                const int row = u.pm * 256 + ai * 128 + wr * 64 + m * 16 + fr; const float r = rr[ai][m];
                if (pn == 32) {
                    if (wc == 0 && fq < 2) {
#pragma unroll
                        for (int n = 0; n < 2; ++n) *(f32x4*)(GAGB + (size_t)row * 16 + 8 * fq + 4 * n) = acc[ai][0][m][n] * r;
                    }
                } else {
                    bf16* dst;
                    if (pn < 12) dst = P + (size_t)row * PW + 256 * pn;
                    else if (pn < 16) dst = GATES + (size_t)row * 2048 + 256 * (pn - 12);
                    else if (pn < 28) dst = P + (size_t)row * PW + 3072 + 256 * (pn - 16);
                    else dst = GATES + (size_t)row * 2048 + 1024 + 256 * (pn - 28);
                    const bool crow = convt && ((row & 63) >= 61) && (row >= MP - 3);
#pragma unroll
                    for (int bj = 0; bj < 2; ++bj) {
                        f32x4 v0 = acc[ai][bj][m][0] * r, v1 = acc[ai][bj][m][1] * r;
                        if (crow) {
                            const int i = (row & 63) - 61, ch = 256 * (pn - 16) + bj * 128 + wc * 32 + 8 * fq;
                            float* cd = (row < MP) ? convp + (size_t)i * 3072 + ch : convs + ((size_t)((row - MP) >> 6) * 3 + i) * 3072 + ch;
                            *(f32x4*)cd = v0; *(f32x4*)(cd + 4) = v1;
                        }
                        if (gate) {
#pragma unroll
                            for (int k = 0; k < 4; ++k) { v0[k] = silu_f(v0[k]); v1[k] = silu_f(v1[k]); }
                        }
                        u32x4 w; w.x = pg8::cvt_pk_bf16(v0[0], v0[1]); w.y = pg8::cvt_pk_bf16(v0[2], v0[3]); w.z = pg8::cvt_pk_bf16(v1[0], v1[1]); w.w = pg8::cvt_pk_bf16(v1[2], v1[3]);
                        *(u32x4*)(dst + bj * 128 + wc * 32 + 8 * fq) = w;
                    }
                }
            }
    }
};

#define XB_TMO      128
#define XB_XCNT(j)  (256  + 64 * (j))
#define XB_XSUB(j)  (1280 + 64 * (j))
#define XB_XGEN(j)  (2304 + 64 * (j))
#define XB_TOP      3328
#define XB_TOPGEN   3392
#define XCD_BAR_WORDS 3456
#define XB_SPIN_CAP (1u << 18)

__device__ __forceinline__ unsigned xb_ld(unsigned* p)              { return __hip_atomic_load(p, __ATOMIC_RELAXED, __HIP_MEMORY_SCOPE_AGENT); }
__device__ __forceinline__ unsigned xb_add(unsigned* p, unsigned v) { return __hip_atomic_fetch_add(p, v, __ATOMIC_RELAXED, __HIP_MEMORY_SCOPE_AGENT); }
__device__ __forceinline__ unsigned xb_xcc_id() { return (unsigned)__builtin_amdgcn_s_getreg((3 << 11) | 20) & 0xFu; }
#define XB_SPIN(cond, bar) do { unsigned _sp = 0; while (cond) { __builtin_amdgcn_s_sleep(1); \
    if ((++_sp & 255u) == 0u) { if (xb_ld(&(bar)[XB_TMO])) break; if (_sp > XB_SPIN_CAP) { atomicAdd(&(bar)[XB_TMO], 1u); break; } } } } while (0)

struct XcdBarrier {
    unsigned* bar; unsigned x;
    volatile LAS unsigned* st;
};

__device__ __forceinline__ XcdBarrier xcd_barrier_post(unsigned* bar, volatile LAS unsigned* st, int tid) {
    XcdBarrier b; b.bar = bar; b.x = xb_xcc_id(); b.st = st;
    if (tid == 0) (void)xb_add(&bar[XB_XCNT(b.x)], 1u);
    return b;
}
__device__ __forceinline__ void xcd_barrier_complete(unsigned* bar, unsigned x, unsigned& nloc, unsigned& nx) {
    const unsigned G = gridDim.x * gridDim.y * gridDim.z;
    unsigned sum, cnt, mine, sp = 0u;
    for (;;) {
        sum = 0u; cnt = 0u; mine = 0u;
#pragma unroll
        for (unsigned j = 0; j < 16; ++j) { const unsigned c = xb_ld(&bar[XB_XCNT(j)]); sum += c; cnt += (c > 0u) ? 1u : 0u; mine = (j == x) ? c : mine; }
        if (sum == G) break;
        __builtin_amdgcn_s_sleep(1);
        if ((++sp & 255u) == 0u) { if (xb_ld(&bar[XB_TMO])) break; if (sp > XB_SPIN_CAP) { atomicAdd(&bar[XB_TMO], 1u); break; } }
    }
    nloc = mine > 0u ? mine : 1u; nx = cnt > 0u ? cnt : 1u;
}

__device__ __forceinline__ void xcd_barrier(const XcdBarrier& b, int tid) {
    asm volatile("s_waitcnt vmcnt(0)" ::: "memory");
    __syncthreads();
    if (tid == 0) {
        unsigned* bar = b.bar;
        __builtin_amdgcn_s_waitcnt(0);
        unsigned nloc = b.st[0], nx = b.st[1];
        if (nloc == 0u) { xcd_barrier_complete(bar, b.x, nloc, nx); b.st[0] = nloc; b.st[1] = nx; }
        const unsigned old = xb_add(&bar[XB_XSUB(b.x)], 1u);
        const unsigned gen = old / nloc;
        if (old + 1u == (gen + 1u) * nloc) {
            __builtin_amdgcn_fence(__ATOMIC_RELEASE, "agent");
            asm volatile("s_waitcnt vmcnt(0)" ::: "memory");
            const unsigned og = xb_add(&bar[XB_TOP], 1u);
            const unsigned tg = og / nx;
            if (og + 1u == (tg + 1u) * nx) xb_add(&bar[XB_TOPGEN], 1u);
            else XB_SPIN(xb_ld(&bar[XB_TOPGEN]) == tg, bar);
            __builtin_amdgcn_fence(__ATOMIC_ACQUIRE, "agent");
            xb_add(&bar[XB_XGEN(b.x)], 1u);
            asm volatile("s_waitcnt vmcnt(0)" ::: "memory");
        } else {
            XB_SPIN(xb_ld(&bar[XB_XGEN(b.x)]) == gen, bar);
            __builtin_amdgcn_fence(__ATOMIC_ACQUIRE, "agent");
            asm volatile("s_waitcnt vmcnt(0)" ::: "memory");
        }
    }
    __syncthreads();
}

struct Frame {
    LAS unsigned char* lds;
    int tid, lane, wave, G, bid;
    const float* in[22]; float* out; unsigned char* ws;
};

struct TItem { const float* W; const float* gain; bf16* WT; int K, N, mode, item; };
__device__ __forceinline__ void t_issue(const TItem& t, int lane, f32x4 (&a)[8], f32x4 (&b)[8]) {
    const int nblk = (t.N + 127) / 128, kb = t.item / nblk, nb = t.item % nblk, k0 = 32 * kb, n0 = 128 * nb;
    const int n4 = lane & 31, kh = lane >> 5; const bool nok = (n0 + 4 * n4) < t.N;
#pragma unroll
    for (int j = 0; j < 8; ++j) {
        const float* p = t.W + (size_t)(k0 + 2 * (kh + 2 * j)) * t.N + n0 + 4 * n4;
        a[j] = nok ? __builtin_nontemporal_load((const f32x4*)p) : (f32x4){0.f, 0.f, 0.f, 0.f}; b[j] = nok ? __builtin_nontemporal_load((const f32x4*)(p + t.N)) : (f32x4){0.f, 0.f, 0.f, 0.f};
    }
}
__device__ __forceinline__ void t_finish(const TItem& t, LAS float* scr_, int lane, const f32x4 (&a)[8], const f32x4 (&b)[8]) {
    LAS unsigned* scr = (LAS unsigned*)scr_;
    const int nblk = (t.N + 127) / 128, kb = t.item / nblk, nb = t.item % nblk, k0 = 32 * kb, n0 = 128 * nb;
    const int n4 = lane & 31, kh = lane >> 5;
#pragma unroll
    for (int j = 0; j < 8; ++j) {
        const int kp = kh + 2 * j; const float ga = t.gain ? t.gain[k0 + 2 * kp] : 1.f, gb = t.gain ? t.gain[k0 + 2 * kp + 1] : 1.f;
        u32x4 w; w.x = pk2(a[j][0] * ga, b[j][0] * gb); w.y = pk2(a[j][1] * ga, b[j][1] * gb); w.z = pk2(a[j][2] * ga, b[j][2] * gb); w.w = pk2(a[j][3] * ga, b[j][3] * gb);
        *(LAS u32x4*)(scr + kp * 132 + 4 * n4) = w;
    }
    asm volatile("s_waitcnt lgkmcnt(0)" ::: "memory");
    const int kc = lane & 3;
#pragma unroll
    for (int r = 0; r < 8; ++r) {
        const int n = (lane >> 2) + 16 * r, nc = n0 + n; const LAS unsigned* s = scr + (4 * kc) * 132 + n;
        u32x4 o; o.x = s[0]; o.y = s[132]; o.z = s[264]; o.w = s[396];
        if (nc < t.N) { const int row = t.mode == 0 ? nc : (256 * (nc >> 7) + (nc & 127) + (t.mode == 2 ? 128 : 0)); *(u32x4*)(t.WT + (size_t)row * t.K + k0 + 8 * kc) = o; }
    }
    asm volatile("s_waitcnt lgkmcnt(0)" ::: "memory");
}
__device__ __forceinline__ void ffn_item(int r, const float* wg, const float* wu, const float* wd, const float* gain, bf16* Wgu, bf16* Wd, TItem& t) {
    constexpr int I_G = (DM / 32) * (DFF / 128);
    if (r < I_G) { t = TItem{wg, gain, Wgu, DM, DFF, 1, r}; }
    else if (r < 2 * I_G) { t = TItem{wu, gain, Wgu, DM, DFF, 2, r - I_G}; }
    else { t = TItem{wd, nullptr, Wd, DFF, DM, 0, r - 2 * I_G}; }
}
constexpr int FFN_ITEMS = 2 * (DM / 32) * (DFF / 128) + (DFF / 32) * (DM / 128);
__device__ __forceinline__ void convert_ffn(Frame& F, const float* wg, const float* wu, const float* wd, const float* gain, bf16* Wgu, bf16* Wd) {
    LAS float* scr = (LAS float*)(F.lds + F.wave * 16384);
    const int gw = F.bid * NWAVES + F.wave, NGW = F.G * NWAVES;
    f32x4 a0[8], b0[8], a1[8], b1[8]; TItem cur, nxt;
    int it = gw; bool hc = it < FFN_ITEMS;
    if (hc) { ffn_item(it, wg, wu, wd, gain, Wgu, Wd, cur); t_issue(cur, F.lane, a0, b0); }
    while (hc) {
        it += NGW; const bool hn = it < FFN_ITEMS;
        if (hn) { ffn_item(it, wg, wu, wd, gain, Wgu, Wd, nxt); t_issue(nxt, F.lane, a1, b1); }
        t_finish(cur, scr, F.lane, a0, b0);
        cur = nxt; hc = hn;
#pragma unroll
        for (int j = 0; j < 8; ++j) { a0[j] = a1[j]; b0[j] = b1[j]; }
    }
}
constexpr int Q1_D = (DFF / 32) * (DM / 128), Q1_IN = (DM / 32) * ((NIN + 127) / 128), Q1_OUT = (DM / 32) * (DM / 128), Q1_ITEMS = Q1_D + Q1_IN + Q1_OUT;
__device__ __forceinline__ void q1_item(Frame& F, int r, TItem& t) {
    if (r < Q1_D) t = TItem{F.in[I_F1D], nullptr, (bf16*)(F.ws + WS_WD1), DFF, DM, 0, r};
    else if (r < Q1_D + Q1_IN) t = TItem{F.in[I_WIN], F.in[I_MIXN], (bf16*)(F.ws + WS_WIN), DM, NIN, 0, r - Q1_D};
    else t = TItem{F.in[I_WOUT], nullptr, (bf16*)(F.ws + WS_WOUT), DM, DM, 0, r - Q1_D - Q1_IN};
}
template <int QID>
__device__ __forceinline__ void convert_queue(Frame& F, unsigned* ctr, const unsigned* stop) {
    LAS float* scr = (LAS float*)(F.lds + F.wave * 16384);
    constexpr int NIT = QID ? Q1_ITEMS : FFN_ITEMS;
    for (;;) {
        if (stop && (unsigned)__builtin_amdgcn_readfirstlane((int)__hip_atomic_load(stop, __ATOMIC_RELAXED, __HIP_MEMORY_SCOPE_AGENT)) >= 128u) break;
        unsigned base = 0; if (F.lane == 0) base = __hip_atomic_fetch_add(ctr, 4u, __ATOMIC_RELAXED, __HIP_MEMORY_SCOPE_AGENT);
        base = (unsigned)__builtin_amdgcn_readfirstlane((int)base);
        if (base >= (unsigned)NIT) break;
        const int end = ((int)base + 4 < NIT) ? (int)base + 4 : NIT;
        f32x4 a0[8], b0[8], a1[8], b1[8]; TItem cur, nxt;
#define Q_ITEM(r, t) do { if (QID) q1_item(F, (r), t); else ffn_item((r), F.in[I_F2G], F.in[I_F2U], F.in[I_F2D], F.in[I_F2N], (bf16*)(F.ws + WS_WGU2), (bf16*)(F.ws + WS_WD2), t); } while (0)
        int it = (int)base; Q_ITEM(it, cur); t_issue(cur, F.lane, a0, b0);
        for (;;) {
            ++it; const bool hn = it < end;
            if (hn) { Q_ITEM(it, nxt); t_issue(nxt, F.lane, a1, b1); }
            t_finish(cur, scr, F.lane, a0, b0);
            if (!hn) break;
            cur = nxt;
#pragma unroll
            for (int j = 0; j < 8; ++j) { a0[j] = a1[j]; b0[j] = b1[j]; }
        }
#undef Q_ITEM
    }
}

__device__ __forceinline__ void phase_p0(Frame& F) {
    {
        LAS float* scr = (LAS float*)(F.lds + F.wave * 16384);
        const int gw = F.bid * NWAVES + F.wave, NGW = F.G * NWAVES; constexpr int NI = 2 * (DM / 32) * (DFF / 128);
        f32x4 a0[8], b0[8], a1[8], b1[8]; TItem cur, nxt;
        int it = gw; bool hc = it < NI;
        if (hc) { ffn_item(it, F.in[I_F1G], F.in[I_F1U], F.in[I_F1D], F.in[I_F1N], (bf16*)(F.ws + WS_WGU1), (bf16*)(F.ws + WS_WD1), cur); t_issue(cur, F.lane, a0, b0); }
        while (hc) {
            it += NGW; const bool hn = it < NI;
            if (hn) { ffn_item(it, F.in[I_F1G], F.in[I_F1U], F.in[I_F1D], F.in[I_F1N], (bf16*)(F.ws + WS_WGU1), (bf16*)(F.ws + WS_WD1), nxt); t_issue(nxt, F.lane, a1, b1); }
            t_finish(cur, scr, F.lane, a0, b0);
            cur = nxt; hc = hn;
#pragma unroll
            for (int j = 0; j < 8; ++j) { a0[j] = a1[j]; b0[j] = b1[j]; }
        }
    }
    const int gw = F.bid * NWAVES + F.wave, NGW = F.G * NWAVES;
    { u32x4* z = (u32x4*)(F.ws + WS_WIN + (size_t)NIN * DM * 2); const int n16 = (NINP - NIN) * DM * 2 / 16;
      for (int i = F.bid * NTHR + F.tid; i < n16; i += F.G * NTHR) z[i] = (u32x4){0u, 0u, 0u, 0u}; }
    bf16* XB0 = (bf16*)(F.ws + WS_XB0); float* ssq0 = (float*)(F.ws + WS_SSQ0);
    f32x4 v[8], vn[8];
#define XROW(r_) ((const f32x4*)(((r_) < MP) ? F.in[I_XP] + (size_t)(r_) * DM : F.in[I_XS] + (size_t)((r_) - MP) * DM) + F.lane)
    if (gw < MT) { const f32x4* xr = XROW(gw);
#pragma unroll
        for (int j = 0; j < 8; ++j) v[j] = __builtin_nontemporal_load(xr + 64 * j); }
    for (int row = gw; row < MT; row += NGW) {
        const int rn = row + NGW;
        if (rn < MT) { const f32x4* xr = XROW(rn);
#pragma unroll
            for (int j = 0; j < 8; ++j) vn[j] = __builtin_nontemporal_load(xr + 64 * j); }
        float s = 0.f;
#pragma unroll
        for (int j = 0; j < 8; ++j) s += (v[j][0] * v[j][0] + v[j][1] * v[j][1]) + (v[j][2] * v[j][2] + v[j][3] * v[j][3]);
        s = wave_sum(s);
        u32x2* o = (u32x2*)(XB0 + (size_t)row * DM) + F.lane;
#pragma unroll
        for (int j = 0; j < 8; ++j) { u32x2 w; w.x = pk2(v[j][0], v[j][1]); w.y = pk2(v[j][2], v[j][3]); o[64 * j] = w; }
        if (F.lane < 32) ssq0[(size_t)row * 32 + F.lane] = (F.lane == 0) ? s : 0.f;
#pragma unroll
        for (int j = 0; j < 8; ++j) v[j] = vn[j];
    }
#undef XROW
}

__device__ __forceinline__ void resid_fixup(Frame& F, const SplitOrder& S, const float* resp, const float* ress, float* out, bf16* outb, float* ssq, float scale, const float* slab) {
    if (!S.split) return;
    const int nsp = S.nwg - S.G, gw = F.bid * NWAVES + F.wave, NGW = F.G * NWAVES, lane = F.lane;
    for (int task = gw; task < nsp * 256; task += NGW) {
        const int j = task >> 8, r = task & 255; Unit u; S.tile(S.G + j, u);
        const int row = u.pm * 256 + r, col = u.pn * 256 + 4 * lane;
        const float* sp = slab + (size_t)(j * 4) * 65536 + r * 256 + 4 * lane;
        const f32x4 p0 = *(const f32x4*)sp, p1 = *(const f32x4*)(sp + 65536), p2 = *(const f32x4*)(sp + 2 * 65536), p3 = *(const f32x4*)(sp + 3 * 65536);
        const float* rb = (row < MP) ? resp + (size_t)row * DM : ress + (size_t)(row - MP) * DM;
        const f32x4 v = *(const f32x4*)(rb + col) + ((p0 + p1) + (p2 + p3)) * scale;
        *(f32x4*)(out + (size_t)row * DM + col) = v;
        if (outb) { u32x2 w; w.x = pk2(v[0], v[1]); w.y = pk2(v[2], v[3]); *(u32x2*)(outb + (size_t)row * DM + col) = w; }
        float ss = (v[0] * v[0] + v[1] * v[1]) + (v[2] * v[2] + v[3] * v[3]);
        ss += __shfl_xor(ss, 1); ss += __shfl_xor(ss, 2); ss += __shfl_xor(ss, 4); ss += __shfl_xor(ss, 8);
        if ((lane & 15) == 0) ssq[(size_t)row * 32 + u.pn * 4 + (lane >> 4)] = ss;
    }
}
__device__ __forceinline__ float shx(float v, int lane, int o) { return __builtin_bit_cast(float, __builtin_amdgcn_ds_bpermute((lane ^ o) << 2, __builtin_bit_cast(int, v))); }
__device__ __forceinline__ float wave_sum_l(float v, int lane) {
#pragma unroll
    for (int o = 1; o < 64; o <<= 1) v += shx(v, lane, o);
    return v;
}
constexpr int ST = 132, ST2 = 68;
__device__ __forceinline__ bf16x8 rowfrag(const LAS float* buf, int row, int col) {
    const f32x4 lo = *(const LAS f32x4*)(buf + row * ST + col), hi = *(const LAS f32x4*)(buf + row * ST + col + 4);
    u32x4 w; w.x = pk2(lo[0], lo[1]); w.y = pk2(lo[2], lo[3]); w.z = pk2(hi[0], hi[1]); w.w = pk2(hi[2], hi[3]);
    return __builtin_bit_cast(bf16x8, w);
}
__device__ __forceinline__ void write_afrag(bf16* out, const LAS float* buf, int stride, int nks, const LAS float* rs, float sc, int tid) {
    const int total = 4 * nks * 64;
    for (int p = tid; p < total; p += NTHR) {
        const int lane = p & 63, f = p >> 6, ks = f % nks, mt = f / nks, fr = lane & 15, fq = lane >> 4, t = 16 * mt + fr;
        const LAS float* src = buf + t * stride + 32 * ks + 4 * fq;
        const f32x4 lo = *(const LAS f32x4*)src, hi = *(const LAS f32x4*)(src + 16);
        const float s = rs ? sc * rs[t] : sc;
        u32x4 w; w.x = pk2(lo[0] * s, lo[1] * s); w.y = pk2(lo[2] * s, lo[3] * s); w.z = pk2(hi[0] * s, hi[1] * s); w.w = pk2(hi[2] * s, hi[3] * s);
        *(u32x4*)(out + (size_t)p * 8) = w;
    }
}
__device__ __forceinline__ void write_tfrag(bf16* out, const LAS float* buf, const LAS float* rs, int tid) {
    for (int p = tid; p < 16 * 64; p += NTHR) {
        const int lane = p & 63, f = p >> 6, ksp = f & 1, dt = f >> 1, fr = lane & 15, fq = lane >> 4, col = 16 * dt + fr;
        float v[8];
#pragma unroll
        for (int j = 0; j < 8; ++j) { const int t = 32 * ksp + 16 * (j >> 2) + 4 * fq + (j & 3); v[j] = buf[t * ST + col] * (rs ? rs[t] : 1.f); }
        u32x4 w; w.x = pk2(v[0], v[1]); w.y = pk2(v[2], v[3]); w.z = pk2(v[4], v[5]); w.w = pk2(v[6], v[7]);
        *(u32x4*)(out + (size_t)p * 8) = w;
    }
}

#define LDS_BAR() do { asm volatile("s_waitcnt lgkmcnt(0)" ::: "memory"); __builtin_amdgcn_s_barrier(); asm volatile("" ::: "memory"); } while (0)
__device__ __forceinline__ void phase_a(Frame& F, const int aflags) {
    LAS float* qf = (LAS float*)F.lds; LAS float* kf = qf + 64 * ST; LAS float* vf = kf + 64 * ST;
    LAS float* amT = vf + 64 * ST; LAS float* qkb = amT + 64 * ST2; LAS float* gcs = qkb + 64 * ST2; LAS float* bet = gcs + 64; LAS float* eg = bet + 64; LAS float* ksc = eg + 64;
    const bf16* P = (const bf16*)(F.ws + WS_P); const float* GAGB = (const float*)(F.ws + WS_GAGB);
    const int wave = F.wave;
    unsigned short gpre[64]; unsigned ghr[3]; float gcw[4];
#define GDN_PREFETCH_A(itn_, tid_) do { _Pragma("unroll") for (int t = 0; t < 32; ++t) gpre[t] = 0; ghr[0] = ghr[1] = ghr[2] = 0u; gcw[0] = gcw[1] = gcw[2] = gcw[3] = 0.f;     \
        if ((itn_) < NITEM && (tid_) < 384) { const int h_ = (itn_) / NCH, c_ = (itn_) % NCH, ch_ = ((tid_) >> 7) * 1024 + h_ * 128 + ((tid_) & 127); \
        const float* cw_ = F.in[I_CONVW]; gcw[0] = cw_[ch_]; gcw[1] = cw_[3072 + ch_]; gcw[2] = cw_[2 * 3072 + ch_]; gcw[3] = cw_[3 * 3072 + ch_]; \
        if (c_ >= 128) { const unsigned* sc_ = (const unsigned*)(F.in[I_SCONV] + (size_t)(c_ - 128) * 3 * 3072 + ch_); ghr[0] = sc_[0]; ghr[1] = sc_[3072]; ghr[2] = sc_[2 * 3072]; } \
        else if (c_ > 0) { const bf16* pp_ = P + (size_t)(64 * c_ - 3) * PW + 3072 + ch_; ghr[0] = pp_[0]; ghr[1] = pp_[PW]; ghr[2] = pp_[2 * PW]; } \
        const bf16* pr_ = P + (size_t)(64 * c_) * PW + 3072 + ch_; \
        _Pragma("unroll") for (int t = 0; t < 32; ++t) gpre[t] = __builtin_nontemporal_load(pr_ + (size_t)t * PW); } } while (0)
#define GDN_PREFETCH_B(itn_, tid_) do { _Pragma("unroll") for (int t = 32; t < 64; ++t) gpre[t] = 0; \
        if ((itn_) < NITEM && (tid_) < 384) { const int h_ = (itn_) / NCH, c_ = (itn_) % NCH, ch_ = ((tid_) >> 7) * 1024 + h_ * 128 + ((tid_) & 127); \
        const bf16* pr_ = P + (size_t)(64 * c_) * PW + 3072 + ch_; \
        _Pragma("unroll") for (int t = 32; t < 64; ++t) gpre[t] = __builtin_nontemporal_load(pr_ + (size_t)t * PW); } } while (0)
    ghr[0] = ghr[1] = ghr[2] = 0u;
    if (!(aflags & 2)) { const int tid0 = wave * 64 + fresh_lane(); GDN_PREFETCH_A(F.bid, tid0); GDN_PREFETCH_B(F.bid, tid0); }
    if (!(aflags & 2))
    for (int it = F.bid; it < NITEM; it += F.G) {
        const int h = it / NCH, c = it % NCH, item = it;
        const int row0 = 64 * c;
        const int lane = fresh_lane(), tid = wave * 64 + lane, fr = lane & 15, fq = lane >> 4;
        {
            if (tid < 384) {
                const int X = tid >> 7, col = tid & 127;
                const float c0 = gcw[0], c1 = gcw[1], c2 = gcw[2], c3 = gcw[3];
                float x0, x1, x2;
                if (c >= 128) { x0 = __builtin_bit_cast(float, ghr[0]); x1 = __builtin_bit_cast(float, ghr[1]); x2 = __builtin_bit_cast(float, ghr[2]); }
                else if (c > 0) { x0 = bf2f((unsigned short)ghr[0]); x1 = bf2f((unsigned short)ghr[1]); x2 = bf2f((unsigned short)ghr[2]); }
                else { x0 = 0.f; x1 = 0.f; x2 = 0.f; }
                LAS float* dst = (X == 0 ? qf : (X == 1 ? kf : vf)) + col;
#pragma unroll
                for (int t = 0; t < 64; ++t) { const float x3 = bf2f(gpre[t]); float y = x0 * c0; y += x1 * c1; y += x2 * c2; y += x3 * c3; dst[t * ST] = silu_f(y); x0 = x1; x1 = x2; x2 = x3; }
            } else if (tid < 448) {
                const int t = tid - 384; const float ga = GAGB[(size_t)(row0 + t) * 16 + h], gb = GAGB[(size_t)(row0 + t) * 16 + 8 + h];
                const float xx = ga + F.in[I_DTB][h]; const float sp = fmaxf(xx, 0.f) + log1pf(expf(-fabsf(xx)));
                float g = -expf(F.in[I_ALOG][h]) * sp;
#pragma unroll
                for (int o = 1; o < 64; o <<= 1) { const float n = __builtin_bit_cast(float, __builtin_amdgcn_ds_bpermute(((lane - o) & 63) << 2, __builtin_bit_cast(int, g))); if (t >= o) g += n; }
                const float g63 = __builtin_bit_cast(float, __builtin_amdgcn_readlane(__builtin_bit_cast(int, g), 63));
                gcs[t] = g; bet[t] = 1.f / (1.f + expf(-gb)); eg[t] = expf(g); ksc[t] = expf(g63 - g);
                if (t == 63) ((float*)(F.ws + WS_CDG))[item] = expf(g);
            }
            LDS_BAR();
            for (int rr = wave; rr < 128; rr += NWAVES) {
                LAS float* b = (rr < 64 ? qf : kf) + (rr & 63) * ST; const float a0 = b[lane], a1 = b[lane + 64];
                const float ss = wave_sum_l(a0 * a0 + a1 * a1, lane); const float sc = rsqrtf(ss + EPS) * (rr < 64 ? 0.08838834764831845f : 1.f);
                b[lane] = a0 * sc; b[lane + 64] = a1 * sc;
            }
            LDS_BAR();
            {
                const int mat = wave >> 2, mt = wave & 3; const LAS float* asrc = mat ? qf : kf;
                bf16x8 a[4];
#pragma unroll
                for (int ks = 0; ks < 4; ++ks) a[ks] = rowfrag(asrc, 16 * mt + fr, 32 * ks + 8 * fq);
#pragma unroll
                for (int nt = 0; nt < 4; ++nt) {
                    f32x4 acc = {0.f, 0.f, 0.f, 0.f};
#pragma unroll
                    for (int ks = 0; ks < 4; ++ks) acc = __builtin_amdgcn_mfma_f32_16x16x32_bf16(a[ks], rowfrag(kf, 16 * nt + fr, 32 * ks + 8 * fq), acc, 0, 0, 0);
                    const int s = 16 * nt + fr;
#pragma unroll
                    for (int i = 0; i < 4; ++i) {
                        const int t = 16 * mt + 4 * fq + i; const float dec = (t >= s) ? expf(gcs[t] - gcs[s]) : 0.f;
                        if (mat == 0) amT[s * ST2 + t] = (t > s) ? acc[i] * dec * bet[t] : 0.f;
                        else qkb[t * ST2 + s] = acc[i] * dec;
                    }
                }
            }
            LDS_BAR();
            write_afrag((bf16*)(F.ws + WS_QDG + (size_t)item * FR16), qf, ST, 4, eg, 1.f, tid);
            write_afrag((bf16*)(F.ws + WS_QKG + (size_t)item * FR8), qkb, ST2, 2, nullptr, 1.f, tid);
            write_tfrag((bf16*)(F.ws + WS_KDG + (size_t)item * FR16), kf, ksc, tid);
            f32x2 xv[32];
            if (tid < 256) {
                if (tid < 128) {
#pragma unroll
                    for (int t = 0; t < 64; t += 2) xv[t >> 1] = (f32x2){kf[t * ST + tid] * bet[t] * eg[t], kf[(t + 1) * ST + tid] * bet[t + 1] * eg[t + 1]};
                } else {
#pragma unroll
                    for (int t = 0; t < 64; t += 2) xv[t >> 1] = (f32x2){vf[t * ST + tid - 128] * bet[t], vf[(t + 1) * ST + tid - 128] * bet[t + 1]};
                }
            }
            LDS_BAR();
            GDN_PREFETCH_A(it + F.G, tid);
            if (tid < 256 && !(aflags & 1)) {
                int vz; asm volatile("v_mov_b32 %0, 0" : "=v"(vz));
                const LAS float* amv = amT + vz;
                f32x4 cur[16], nxt[16];
#pragma unroll
                for (int g = 0; g < 16; ++g) cur[g] = *(const LAS f32x4*)(amv + 4 * g);
#pragma unroll
                for (int s = 0; s < 63; ++s) {
                    if (s + 1 < 63) {
#pragma unroll
                        for (int g = (s + 2) >> 2; g < 16; ++g) nxt[g] = *(const LAS f32x4*)(amv + (s + 1) * ST2 + 4 * g);
                    }
                    const float xs = (s & 1) ? xv[s >> 1].y : xv[s >> 1].x; const f32x2 xs2 = {xs, xs};
#pragma unroll
                    for (int g = (s + 1) >> 2; g < 16; ++g) { xv[2 * g] -= (f32x2){cur[g][0], cur[g][1]} * xs2; xv[2 * g + 1] -= (f32x2){cur[g][2], cur[g][3]} * xs2; }
#pragma unroll
                    for (int g = 0; g < 16; ++g) cur[g] = nxt[g];
                    __builtin_amdgcn_sched_barrier(0);
                }
                LAS float* dst = (tid < 128) ? qf + tid : kf + (tid - 128);
#pragma unroll
                for (int t = 0; t < 64; t += 2) { dst[t * ST] = xv[t >> 1].x; dst[(t + 1) * ST] = xv[t >> 1].y; }
            }
            LDS_BAR();
            GDN_PREFETCH_B(it + F.G, tid);
            write_afrag((bf16*)(F.ws + WS_NW + (size_t)item * FR16), qf, ST, 4, nullptr, -1.f, tid);
            {
                bf16* U = (bf16*)(F.ws + WS_UG + (size_t)item * FR16);
                for (int p = tid; p < 32 * 64; p += NTHR) {
                    const int ln = p & 63, f = p >> 6, mt = f & 3, sl = f >> 2, r = ln & 15, q = ln >> 4;
                    const LAS float* s = kf + (16 * mt + 4 * q) * ST + 16 * sl + r;
                    u32x2 w; w.x = pk2(s[0], s[ST]); w.y = pk2(s[2 * ST], s[3 * ST]); *(u32x2*)(U + (size_t)p * 4) = w;
                }
            }
            LDS_BAR();
        }
    }
    unsigned short pre[64];
    const int it0r = (F.bid + F.G / 2) % F.G;
    if (!(aflags & 4) && it0r < NITEM) {
        const int tid0 = wave * 64 + fresh_lane();
        if (tid0 < 384) { const bf16* pr = P + (size_t)(64 * (it0r % NCH)) * PW + (tid0 >> 7) * 1024 + (it0r / NCH) * 128 + (tid0 & 127);
#pragma unroll
            for (int t = 0; t < 64; ++t) pre[t] = __builtin_nontemporal_load(pr + (size_t)t * PW); }
    }
    if (!(aflags & 4))
    for (int it = it0r; it < NITEM; it += F.G) {
        const int h = it / NCH, c = it % NCH, item = it;
        const int row0 = 64 * c;
        const int lane = fresh_lane(), tid = wave * 64 + lane, fr = lane & 15, fq = lane >> 4;
        {
            const float lg = logf(1.f - exp2f(-5.f - (float)h));
            if (tid < 384) {
                const int X = tid >> 7, col = tid & 127;
                LAS float* dst = (X == 0 ? qf : (X == 1 ? kf : vf)) + col;
#pragma unroll
                for (int t = 0; t < 64; ++t) dst[t * ST] = bf2f(pre[t]);
                const int itn = it + F.G;
                if (itn < NITEM) { const bf16* pr = P + (size_t)(64 * (itn % NCH)) * PW + X * 1024 + (itn / NCH) * 128 + col;
#pragma unroll
                    for (int t = 0; t < 64; ++t) pre[t] = __builtin_nontemporal_load(pr + (size_t)t * PW); }
            } else if (tid < 448) { const int t = tid - 384; eg[t] = expf((float)(t + 1) * lg); ksc[t] = expf((float)(63 - t) * lg); }
            LDS_BAR();
            {
                const float pos0 = (c < 128) ? (float)(64 * c) : 4096.f;
                const double invd = exp(-(double)(tid & 63) * (9.210340371976184 / 64.0)) * 0.15915494309189535;
#pragma unroll 2
                for (int r = 0; r < 8; ++r) {
                    const int idx = tid + NTHR * r, t = idx >> 6, i = idx & 63;
                    double rev = (double)(pos0 + (float)t) * invd; rev -= rint(rev);
                    const float rf = (float)rev; const float sn = __builtin_amdgcn_sinf(rf), cs = __builtin_amdgcn_cosf(rf);
                    const float q1 = qf[t * ST + i], q2 = qf[t * ST + i + 64], k1 = kf[t * ST + i], k2 = kf[t * ST + i + 64];
                    qf[t * ST + i] = (q1 * cs - q2 * sn) * 0.08838834764831845f; qf[t * ST + i + 64] = (q1 * sn + q2 * cs) * 0.08838834764831845f;
                    kf[t * ST + i] = k1 * cs - k2 * sn; kf[t * ST + i + 64] = k1 * sn + k2 * cs;
                }
            }
            LDS_BAR();
            if (wave < 4) {
                const int mt = wave; bf16x8 a[4];
#pragma unroll
                for (int ks = 0; ks < 4; ++ks) a[ks] = rowfrag(qf, 16 * mt + fr, 32 * ks + 8 * fq);
#pragma unroll
                for (int nt = 0; nt < 4; ++nt) {
                    f32x4 acc = {0.f, 0.f, 0.f, 0.f};
#pragma unroll
                    for (int ks = 0; ks < 4; ++ks) acc = __builtin_amdgcn_mfma_f32_16x16x32_bf16(a[ks], rowfrag(kf, 16 * nt + fr, 32 * ks + 8 * fq), acc, 0, 0, 0);
                    const int s = 16 * nt + fr;
#pragma unroll
                    for (int i = 0; i < 4; ++i) { const int t = 16 * mt + 4 * fq + i; qkb[t * ST2 + s] = (t >= s) ? acc[i] * expf((float)(t - s) * lg) : 0.f; }
                }
            }
            LDS_BAR();
            write_afrag((bf16*)(F.ws + WS_QDR + (size_t)item * FR16), qf, ST, 4, eg, 1.f, tid);
            write_afrag((bf16*)(F.ws + WS_SCR + (size_t)item * FR8), qkb, ST2, 2, nullptr, 1.f, tid);
            write_tfrag((bf16*)(F.ws + WS_KDR + (size_t)item * FR16), kf, ksc, tid);
            write_tfrag((bf16*)(F.ws + WS_VR + (size_t)item * FR16), vf, nullptr, tid);
            LDS_BAR();
        }
    }
}

__device__ __forceinline__ bf16x8 pack_acc2(const f32x4& a, const f32x4& b) {
    u32x4 w; w.x = pk2(a[0], a[1]); w.y = pk2(a[2], a[3]); w.z = pk2(b[0], b[1]); w.w = pk2(b[2], b[3]);
    return __builtin_bit_cast(bf16x8, w);
}
__device__ __forceinline__ void run_chain(Frame& F, int type, int item0, int nsteps, int ncw, int slice0, const float* S0, float* Sout) {
    const int tid = F.tid, lane = F.lane, wave = F.wave, fr = lane & 15, fq = lane >> 4;
    const bool comp = wave < ncw; const int sl = slice0 + wave;
    const unsigned char* srcW = F.ws + WS_NW + (size_t)tid * 16; const unsigned char* srcKD = F.ws + (type ? WS_KDG : WS_KDR) + (size_t)tid * 16;
    const unsigned char* UV = F.ws + (type ? WS_UG : WS_VR) + (size_t)sl * 2048 + (size_t)lane * (type ? 8 : 16);
    const float* CD = (const float*)(F.ws + WS_CDG);
    unsigned char* SP = F.ws + WS_SP + (size_t)type * NITEM * 32768 + (size_t)(sl * 4 * 64 + lane) * 16; unsigned char* DL = F.ws + WS_DL + (size_t)(sl * 2 * 64 + lane) * 16;
    const int head = item0 / NCH; const float cd_ret = expf(64.f * logf(1.f - exp2f(-5.f - (float)head)));
    u32x4 ra0, ra1, ra2, ra3, rb0, rb1, rb2, rb3, ua0, ua1, ub0, ub1;
    ra0 = ra1 = ra2 = ra3 = rb0 = rb1 = rb2 = rb3 = ua0 = ua1 = ub0 = ub1 = (u32x4){0u, 0u, 0u, 0u};
#define CH_GLOAD(q0, q1, q2, q3, item) do { const unsigned char* kd_ = srcKD + (size_t)(item) * FR16; q2 = *(const u32x4*)kd_; q3 = *(const u32x4*)(kd_ + 8192); \
        if (type) { const unsigned char* w_ = srcW + (size_t)(item) * FR16; q0 = *(const u32x4*)w_; q1 = *(const u32x4*)(w_ + 8192); } } while (0)
#define CH_LSTORE(q0, q1, q2, q3, buf) do { LAS unsigned char* d_ = F.lds + (buf) * 32768 + tid * 16; *(LAS u32x4*)(d_ + 16384) = q2; *(LAS u32x4*)(d_ + 16384 + 8192) = q3; \
        if (type) { *(LAS u32x4*)d_ = q0; *(LAS u32x4*)(d_ + 8192) = q1; } } while (0)
#define CH_LOADUV(d0, d1, item) do { const unsigned char* p_ = UV + (size_t)(item) * FR16; \
        if (type) { const u32x2 a_ = *(const u32x2*)p_, b_ = *(const u32x2*)(p_ + 512), c_ = *(const u32x2*)(p_ + 1024), e_ = *(const u32x2*)(p_ + 1536); d0 = (u32x4){a_.x, a_.y, b_.x, b_.y}; d1 = (u32x4){c_.x, c_.y, e_.x, e_.y}; } \
        else { d0 = *(const u32x4*)p_; d1 = *(const u32x4*)(p_ + 1024); } } while (0)
#define CH_BAR() do { asm volatile("s_waitcnt lgkmcnt(0)" ::: "memory"); __builtin_amdgcn_s_barrier(); asm volatile("" ::: "memory"); } while (0)
    CH_GLOAD(ra0, ra1, ra2, ra3, item0); CH_LSTORE(ra0, ra1, ra2, ra3, 0);
    if (nsteps > 1) CH_GLOAD(rb0, rb1, rb2, rb3, item0 + 1);
    f32x4 S[8];
#pragma unroll
    for (int dt = 0; dt < 8; ++dt) {
        S[dt] = (f32x4){0.f, 0.f, 0.f, 0.f};
        if (S0 && comp) {
#pragma unroll
            for (int i = 0; i < 4; ++i) S[dt][i] = S0[(size_t)(16 * dt + 4 * fq + i) * 128 + 16 * sl + fr];
        }
    }
    if (comp) { CH_LOADUV(ua0, ua1, item0); if (nsteps > 1) CH_LOADUV(ub0, ub1, item0 + 1); }
    float cdn = type ? CD[item0] : cd_ret;
    CH_BAR();
#define CH_STEP(p0, p1, p2, p3, up0, up1, q0, q1, q2, q3, ST_) do { \
        const int st_ = (ST_), item = item0 + st_; \
        if (st_ + 2 < nsteps) CH_GLOAD(p0, p1, p2, p3, item + 2); \
        const float cd = cdn; if (type && st_ + 1 < nsteps) cdn = CD[item + 1]; \
        if (comp) { \
            const LAS unsigned char* lb = F.lds + (st_ & 1) * 32768 + lane * 16; \
            bf16x8 Sb[4]; \
            _Pragma("unroll") for (int ks = 0; ks < 4; ++ks) { Sb[ks] = pack_acc2(S[2 * ks], S[2 * ks + 1]); *(bf16x8*)(SP + (size_t)item * 32768 + (size_t)ks * 1024) = Sb[ks]; } \
            bf16x8 db0, db1; \
            if (type) { \
                f32x4 dl[4]; \
                dl[0] = (f32x4){bf2f(up0.x & 0xffff), bf2f(up0.x >> 16), bf2f(up0.y & 0xffff), bf2f(up0.y >> 16)}; \
                dl[1] = (f32x4){bf2f(up0.z & 0xffff), bf2f(up0.z >> 16), bf2f(up0.w & 0xffff), bf2f(up0.w >> 16)}; \
                dl[2] = (f32x4){bf2f(up1.x & 0xffff), bf2f(up1.x >> 16), bf2f(up1.y & 0xffff), bf2f(up1.y >> 16)}; \
                dl[3] = (f32x4){bf2f(up1.z & 0xffff), bf2f(up1.z >> 16), bf2f(up1.w & 0xffff), bf2f(up1.w >> 16)}; \
                _Pragma("unroll") for (int ks = 0; ks < 4; ++ks) \
                    _Pragma("unroll") for (int mt = 0; mt < 4; ++mt) dl[mt] = __builtin_amdgcn_mfma_f32_16x16x32_bf16(*(const LAS bf16x8*)(lb + (mt * 4 + ks) * 1024), Sb[ks], dl[mt], 0, 0, 0); \
                db0 = pack_acc2(dl[0], dl[1]); db1 = pack_acc2(dl[2], dl[3]); \
                *(bf16x8*)(DL + (size_t)item * FR16) = db0; *(bf16x8*)(DL + (size_t)item * FR16 + 1024) = db1; \
            } else { db0 = __builtin_bit_cast(bf16x8, up0); db1 = __builtin_bit_cast(bf16x8, up1); } \
            if (st_ + 2 < nsteps) CH_LOADUV(up0, up1, item + 2); \
            _Pragma("unroll") for (int dt = 0; dt < 8; ++dt) S[dt] = S[dt] * cd; \
            _Pragma("unroll") for (int dt = 0; dt < 8; ++dt) S[dt] = __builtin_amdgcn_mfma_f32_16x16x32_bf16(*(const LAS bf16x8*)(lb + 16384 + (dt * 2 + 0) * 1024), db0, S[dt], 0, 0, 0); \
            _Pragma("unroll") for (int dt = 0; dt < 8; ++dt) S[dt] = __builtin_amdgcn_mfma_f32_16x16x32_bf16(*(const LAS bf16x8*)(lb + 16384 + (dt * 2 + 1) * 1024), db1, S[dt], 0, 0, 0); \
        } \
        if (st_ + 1 < nsteps) CH_LSTORE(q0, q1, q2, q3, (st_ + 1) & 1); \
        CH_BAR(); \
    } while (0)
    for (int st = 0; st < nsteps; st += 2) {
        CH_STEP(ra0, ra1, ra2, ra3, ua0, ua1, rb0, rb1, rb2, rb3, st);
        if (st + 1 < nsteps) CH_STEP(rb0, rb1, rb2, rb3, ub0, ub1, ra0, ra1, ra2, ra3, st + 1);
    }
#undef CH_STEP
#undef CH_BAR
#undef CH_GLOAD
#undef CH_LSTORE
#undef CH_LOADUV
    if (comp) {
#pragma unroll
        for (int dt = 0; dt < 8; ++dt)
#pragma unroll
            for (int i = 0; i < 4; ++i) Sout[(size_t)(16 * dt + 4 * fq + i) * 128 + 16 * sl + fr] = S[dt][i];
    }
    __syncthreads();
}
constexpr int RB = 34816;
#define DMA16(gp, ldsoff) __builtin_amdgcn_global_load_lds((const unsigned*)(gp), (LAS unsigned*)(F.lds + (ldsoff)), 16, 0, 0)
template <int NLD>
__device__ __forceinline__ void chain_loader(Frame& F, const unsigned char* g0, const unsigned char* g1, int l0, int l1, int lane) {
    constexpr int N0 = NLD < 4 ? NLD : 4;
    u32x4 R0[NLD], R1[NLD], R2[NLD], R3[NLD], R4[NLD];
#define L_LD(R, k) do { const size_t go_ = (size_t)(k) * FR16; _Pragma("unroll") for (int i = 0; i < N0; ++i) R[i] = *(const u32x4*)(g0 + go_ + i * 1024); \
        if (NLD == 8) { _Pragma("unroll") for (int i = 0; i < 4; ++i) R[(NLD == 8 ? 4 : 0) + i] = *(const u32x4*)(g1 + go_ + i * 1024); } } while (0)
#define L_ST(R, k) do { LAS unsigned char* d_ = F.lds + ((k) & 3) * RB + lane * 16; _Pragma("unroll") for (int i = 0; i < N0; ++i) *(LAS u32x4*)(d_ + l0 + i * 1024) = R[i]; \
        if (NLD == 8) { _Pragma("unroll") for (int i = 0; i < 4; ++i) *(LAS u32x4*)(d_ + l1 + i * 1024) = R[(NLD == 8 ? 4 : 0) + i]; } } while (0)
#define L_BAR() do { asm volatile("s_waitcnt lgkmcnt(0)" ::: "memory"); __builtin_amdgcn_s_barrier(); asm volatile("" ::: "memory"); } while (0)
    L_LD(R0, 0); L_LD(R1, 1); L_LD(R2, 2); L_LD(R3, 3); L_LD(R4, 4);
    L_ST(R0, 0); L_LD(R0, 5); L_ST(R1, 1); L_LD(R1, 6); L_BAR();
    for (int s = 0; s < 120; s += 10) {
        L_ST(R2, s + 2); L_LD(R2, s + 7); L_ST(R3, s + 3); L_LD(R3, s + 8); L_BAR();
        L_ST(R4, s + 4); L_LD(R4, s + 9); L_ST(R0, s + 5); L_LD(R0, s + 10); L_BAR();
        L_ST(R1, s + 6); L_LD(R1, s + 11); L_ST(R2, s + 7); L_LD(R2, s + 12); L_BAR();
        L_ST(R3, s + 8); L_LD(R3, s + 13); L_ST(R4, s + 9); L_LD(R4, s + 14); L_BAR();
        L_ST(R0, s + 10); L_LD(R0, s + 15); L_ST(R1, s + 11); L_LD(R1, s + 16); L_BAR();
    }
    L_ST(R2, 122); L_LD(R2, 127); L_ST(R3, 123); L_BAR();
    L_ST(R4, 124); L_ST(R0, 125); L_BAR();
    L_ST(R1, 126); L_ST(R2, 127); L_BAR();
    L_BAR();
#undef L_LD
#undef L_ST
#undef L_BAR
}
__device__ __forceinline__ void run_chain_long(Frame& F, int type, int item0, int nsteps, int sl, float* Sout, const int bflags) {
    const int lane = F.lane, wave = F.wave, fr = lane & 15, fq = lane >> 4;
    if (wave == 0) {
        const float* CD = (const float*)(F.ws + WS_CDG);
        unsigned char* SP = F.ws + WS_SP + (size_t)type * NITEM * 32768 + (size_t)(sl * 4 * 64 + lane) * 16; unsigned char* DL = F.ws + WS_DL + (size_t)(sl * 2 * 64 + lane) * 16;
        const int head = item0 / NCH; const float cd_ret = expf(64.f * logf(1.f - exp2f(-5.f - (float)head)));
        f32x4 S[8];
#pragma unroll
        for (int dt = 0; dt < 8; ++dt) S[dt] = (f32x4){0.f, 0.f, 0.f, 0.f};
        LAS float* cdl = (LAS float*)(F.lds + 4 * RB);
        for (int i = lane; i < nsteps; i += 64) cdl[i] = type ? CD[item0 + i] : cd_ret;
        asm volatile("s_waitcnt vmcnt(0) lgkmcnt(0)" ::: "memory"); __builtin_amdgcn_s_barrier(); asm volatile("" ::: "memory");
        for (int st = 0; st < nsteps; ++st) {
            const int item = item0 + st; const float cd = cdl[st];
            const LAS unsigned char* lb = F.lds + (st & 3) * RB + lane * 16;
            bf16x8 Sb[4];
#pragma unroll
            for (int ks = 0; ks < 4; ++ks) { Sb[ks] = pack_acc2(S[2 * ks], S[2 * ks + 1]); *(bf16x8*)(SP + (size_t)item * 32768 + (size_t)ks * 1024) = Sb[ks]; }
            bf16x8 db0, db1;
            if (type) {
                const LAS unsigned char* ub = F.lds + (st & 3) * RB + 32768 + lane * 8;
                f32x4 dl[4];
#pragma unroll
                for (int mt = 0; mt < 4; ++mt) { const u32x2 u = *(const LAS u32x2*)(ub + mt * 512); dl[mt] = (f32x4){bf2f(u.x & 0xffff), bf2f(u.x >> 16), bf2f(u.y & 0xffff), bf2f(u.y >> 16)}; }
#pragma unroll
                for (int ks = 0; ks < 4; ++ks)
#pragma unroll
                    for (int mt = 0; mt < 4; ++mt) dl[mt] = __builtin_amdgcn_mfma_f32_16x16x32_bf16(*(const LAS bf16x8*)(lb + (mt * 4 + ks) * 1024), Sb[ks], dl[mt], 0, 0, 0);
                db0 = pack_acc2(dl[0], dl[1]); db1 = pack_acc2(dl[2], dl[3]);
                *(bf16x8*)(DL + (size_t)item * FR16) = db0; *(bf16x8*)(DL + (size_t)item * FR16 + 1024) = db1;
            } else { db0 = *(const LAS bf16x8*)(lb + 32768); db1 = *(const LAS bf16x8*)(lb + 32768 + 1024); }
#pragma unroll
            for (int dt = 0; dt < 8; ++dt) S[dt] = S[dt] * cd;
#pragma unroll
            for (int dt = 0; dt < 8; ++dt) S[dt] = __builtin_amdgcn_mfma_f32_16x16x32_bf16(*(const LAS bf16x8*)(lb + 16384 + (dt * 2 + 0) * 1024), db0, S[dt], 0, 0, 0);
#pragma unroll
            for (int dt = 0; dt < 8; ++dt) S[dt] = __builtin_amdgcn_mfma_f32_16x16x32_bf16(*(const LAS bf16x8*)(lb + 16384 + (dt * 2 + 1) * 1024), db1, S[dt], 0, 0, 0);
            if (st & 1) { asm volatile("s_waitcnt lgkmcnt(0)" ::: "memory"); __builtin_amdgcn_s_barrier(); asm volatile("" ::: "memory"); }
        }
#pragma unroll
        for (int dt = 0; dt < 8; ++dt)
#pragma unroll
            for (int i = 0; i < 4; ++i) Sout[(size_t)(16 * dt + 4 * fq + i) * 128 + 16 * sl + fr] = S[dt][i];
    } else {
        const unsigned char* srcW = F.ws + WS_NW + (size_t)item0 * FR16 + (size_t)lane * 16;
        const unsigned char* srcKD = F.ws + (type ? WS_KDG : WS_KDR) + (size_t)item0 * FR16 + (size_t)lane * 16;
        const unsigned char* srcUV = F.ws + (type ? WS_UG : WS_VR) + (size_t)item0 * FR16 + (size_t)sl * 2048 + (size_t)lane * 16;
        const int w4 = (wave - 1) * 4;
        if (wave <= 4) {
            if (type) chain_loader<8>(F, srcW + w4 * 1024, srcKD + w4 * 1024, w4 * 1024, 16384 + w4 * 1024, lane);
            else chain_loader<4>(F, srcKD + w4 * 1024, nullptr, 16384 + w4 * 1024, 0, lane);
        } else if (wave == 5) chain_loader<2>(F, srcUV, nullptr, 32768, 0, lane);
        else { for (int st = 0; st < 65; ++st) { __builtin_amdgcn_s_barrier(); asm volatile("" ::: "memory"); } }
    }
    __syncthreads();
}
__device__ __forceinline__ void phase_b(Frame& F, const int bflags) {
    const int b = F.bid;
    if (b < 128) {
        const int head = b & 7, slice = (b >> 3) & 7, type = b >> 6;
        run_chain_long(F, type, head * NCH, 128, slice, F.out + (type ? O_GDNP : O_RETP) + (size_t)head * 16384, bflags);
        if (F.tid == 0) __hip_atomic_fetch_add((unsigned*)(F.ws + WS_QCTR + 128), 1u, __ATOMIC_RELAXED, __HIP_MEMORY_SCOPE_AGENT);
    } else {
        for (int idx = b - 128; idx < 256; idx += F.G - 128) {
            const int type = idx >> 7, bb = (idx >> 3) & 15, head = idx & 7;
            run_chain(F, type, head * NCH + 128 + bb, 1, 8, 0, F.in[type ? I_SGDN : I_SRET] + (size_t)(bb * 8 + head) * 16384,
                      F.out + (type ? O_GDNS : O_RETS) + (size_t)(bb * 8 + head) * 16384);
        }
    }
    convert_queue<0>(F, (unsigned*)(F.ws + WS_QCTR), (const unsigned*)(F.ws + WS_QCTR + 128));
}

__device__ __forceinline__ void phase_c(Frame& F, const int cflags) {
    const int wave = F.wave, mt = wave & 3, grp = wave >> 2;
    const bf16* GATES = (const bf16*)(F.ws + WS_GATES); bf16* O = (bf16*)(F.ws + WS_O);
    LAS unsigned char* gb = F.lds + grp * 49152;
    LAS unsigned char* ew = F.lds + 98304 + wave * 4352;
    u32x4 fb[12]; bf16x8 aq[4], ak[2]; u32x4 gin[4]; float nwv[8];
#define C_LOAD(it_, lane_) do { const int type_ = (it_) / NITEM, rem_ = (it_) % NITEM, h_ = rem_ / NCH, c_ = rem_ % NCH; \
        const unsigned char* QD_ = F.ws + (type_ ? WS_QDG : WS_QDR) + (size_t)rem_ * FR16; const unsigned char* QK_ = F.ws + (type_ ? WS_QKG : WS_SCR) + (size_t)rem_ * FR8; \
        const unsigned char* SP_ = F.ws + WS_SP + ((size_t)type_ * NITEM + rem_) * 32768; const unsigned char* DV_ = F.ws + (type_ ? WS_DL : WS_VR) + (size_t)rem_ * FR16; \
        const size_t rb_ = (size_t)(64 * c_ + 16 * mt) * 2048 + type_ * 1024 + h_ * 128; \
        _Pragma("unroll") for (int j = 0; j < 12; ++j) { const int f = mt * 12 + j; fb[j] = __builtin_nontemporal_load((const u32x4*)((f < 32 ? SP_ + (size_t)f * 1024 : DV_ + (size_t)(f - 32) * 1024) + (size_t)(lane_) * 16)); } \
        _Pragma("unroll") for (int ks = 0; ks < 4; ++ks) aq[ks] = __builtin_nontemporal_load((const bf16x8*)(QD_ + (size_t)((mt * 4 + ks) * 64 + (lane_)) * 16)); \
        _Pragma("unroll") for (int k2 = 0; k2 < 2; ++k2) ak[k2] = __builtin_nontemporal_load((const bf16x8*)(QK_ + (size_t)((mt * 2 + k2) * 64 + (lane_)) * 16)); \
        _Pragma("unroll") for (int q = 0; q < 4; ++q) gin[q] = __builtin_nontemporal_load((const u32x4*)(GATES + rb_ + (size_t)((lane_) >> 2) * 2048 + ((lane_) & 3) * 32 + q * 8)); \
        const float* nw_ = type_ ? F.in[I_GDNN] : F.in[I_RETN] + h_ * 128; \
        _Pragma("unroll") for (int sl = 0; sl < 8; ++sl) nwv[sl] = nw_[16 * sl + ((lane_) & 15)]; } while (0)
    const int it0 = F.bid * 2 + grp;
    if (it0 < 2 * NITEM) { const int l0 = fresh_lane(); C_LOAD(it0, l0); }
    for (int it = it0; it < 2 * NITEM; it += 2 * F.G) {
        const int lane = fresh_lane(), fr = lane & 15, fq = lane >> 4;
        const int type = it / NITEM, rem = it % NITEM, h = rem / NCH, c = rem % NCH;
        const size_t rowbase = (size_t)(64 * c + 16 * mt) * 2048 + type * 1024 + h * 128;
        const int erow = lane >> 2, echk = lane & 3;
#pragma unroll
        for (int j = 0; j < 12; ++j) *(LAS u32x4*)(gb + (mt * 12 + j) * 1024 + lane * 16) = fb[j];
#pragma unroll
        for (int q = 0; q < 4; ++q) *(LAS u32x4*)(ew + erow * 272 + echk * 64 + q * 16) = gin[q];
        bf16x8 caq[4], cak[2]; float cnw[8];
#pragma unroll
        for (int ks = 0; ks < 4; ++ks) caq[ks] = aq[ks];
        cak[0] = ak[0]; cak[1] = ak[1];
#pragma unroll
        for (int sl = 0; sl < 8; ++sl) cnw[sl] = nwv[sl];
        if (it + 2 * F.G < 2 * NITEM) C_LOAD(it + 2 * F.G, lane);
        asm volatile("s_waitcnt lgkmcnt(0)" ::: "memory"); __builtin_amdgcn_s_barrier(); asm volatile("" ::: "memory");
        f32x4 o[8];
#pragma unroll
        for (int sl = 0; sl < 8; ++sl) {
            f32x4 acc = {0.f, 0.f, 0.f, 0.f};
#pragma unroll
            for (int ks = 0; ks < 4; ++ks) acc = __builtin_amdgcn_mfma_f32_16x16x32_bf16(caq[ks], *(const LAS bf16x8*)(gb + (sl * 4 + ks) * 1024 + lane * 16), acc, 0, 0, 0);
#pragma unroll
            for (int k2 = 0; k2 < 2; ++k2) acc = __builtin_amdgcn_mfma_f32_16x16x32_bf16(cak[k2], *(const LAS bf16x8*)(gb + (32 + sl * 2 + k2) * 1024 + lane * 16), acc, 0, 0, 0);
            o[sl] = acc;
        }
#pragma unroll
        for (int i = 0; i < 4; ++i) {
            float ss = 0.f;
#pragma unroll
            for (int sl = 0; sl < 8; ++sl) ss += o[sl][i] * o[sl][i];
            ss += __shfl_xor(ss, 1); ss += __shfl_xor(ss, 2); ss += __shfl_xor(ss, 4); ss += __shfl_xor(ss, 8);
            const float rn = rsqrtf(ss * (1.f / 128.f) + EPS);
            LAS unsigned short* er = (LAS unsigned short*)(ew + (4 * fq + i) * 272) + fr;
#pragma unroll
            for (int sl = 0; sl < 8; ++sl) { const float g = bf2f(er[16 * sl]); er[16 * sl] = (unsigned short)f2bf(o[sl][i] * rn * cnw[sl] * g); }
        }
        asm volatile("s_waitcnt lgkmcnt(0)" ::: "memory");
#pragma unroll
        for (int q = 0; q < 4; ++q) *(u32x4*)(O + rowbase + (size_t)erow * 2048 + echk * 32 + q * 8) = *(const LAS u32x4*)(ew + erow * 272 + echk * 64 + q * 16);
        asm volatile("s_waitcnt lgkmcnt(0)" ::: "memory"); __builtin_amdgcn_s_barrier(); asm volatile("" ::: "memory");
    }
#undef C_LOAD
}

__device__ __forceinline__ void phase_final(Frame& F, const SplitOrder& S) {
    const int gw = F.bid * NWAVES + F.wave, NGW = F.G * NWAVES; const float* g = F.in[I_FINN]; const float* slab = (const float*)(F.ws + WS_SLAB);
    LAS unsigned char* tab = F.lds;
    for (int i = F.tid; i < (MT / 256) * 8; i += NTHR) tab[i] = 0;
    __syncthreads();
    if (S.split && F.tid < S.nwg - S.G) { Unit u; S.tile((long)S.G + F.tid, u); tab[u.pm * 8 + u.pn] = (unsigned char)(F.tid + 1); }
    __syncthreads();
    const f32x4* gr = (const f32x4*)g + F.lane; f32x4 gg[8];
#pragma unroll
    for (int j = 0; j < 8; ++j) gg[j] = gr[64 * j];
    f32x4 v[8], vn[8];
    if (gw < MT) { const f32x4* xr = (const f32x4*)(F.out + (size_t)gw * DM) + F.lane;
#pragma unroll
        for (int j = 0; j < 8; ++j) v[j] = xr[64 * j]; }
    for (int row = gw; row < MT; row += NGW) {
        const int rn = row + NGW;
        if (rn < MT) { const f32x4* xr = (const f32x4*)(F.out + (size_t)rn * DM) + F.lane;
#pragma unroll
            for (int j = 0; j < 8; ++j) vn[j] = xr[64 * j]; }
        const int pm = row >> 8, r = row & 255;
#pragma unroll
        for (int j = 0; j < 8; ++j) {
            const int t = tab[pm * 8 + j];
            if (t) { const float* sp = slab + (size_t)((t - 1) * 4) * 65536 + r * 256 + 4 * F.lane;
                const f32x4 p0 = *(const f32x4*)sp, p1 = *(const f32x4*)(sp + 65536), p2 = *(const f32x4*)(sp + 2 * 65536), p3 = *(const f32x4*)(sp + 3 * 65536);
                v[j] += ((p0 + p1) + (p2 + p3)) * 0.5f; }
        }
        float ss = 0.f;
#pragma unroll
        for (int j = 0; j < 8; ++j) ss += (v[j][0] * v[j][0] + v[j][1] * v[j][1]) + (v[j][2] * v[j][2] + v[j][3] * v[j][3]);
        ss = wave_sum(ss); const float rr = rsqrtf(ss * (1.f / DM) + EPS);
        f32x4* xo = (f32x4*)(F.out + (size_t)row * DM) + F.lane;
#pragma unroll
        for (int j = 0; j < 8; ++j) xo[64 * j] = v[j] * rr * gg[j];
#pragma unroll
        for (int j = 0; j < 8; ++j) v[j] = vn[j];
    }
}

__global__ void __launch_bounds__(NTHR) mixer_fwd(Args args) {
    extern __shared__ __attribute__((aligned(16))) unsigned char lds_raw[];
    Frame F;
    F.lds = (LAS unsigned char*)lds_raw; F.wave = __builtin_amdgcn_readfirstlane(threadIdx.x >> 6); F.tid = 0; F.lane = 0;
    F.G = gridDim.x; F.bid = blockIdx.x; F.out = args.out; F.ws = args.ws;
#pragma unroll
    for (int i = 0; i < 22; ++i) F.in[i] = args.in[i];
    const int lo = args.ph_lo, hi = args.ph_hi;
    { const int t0 = F.wave * 64 + fresh_lane(); if (t0 < 16) ((LAS unsigned*)(F.lds + LDS_BYTES - 64))[t0] = 0u; }
    __syncthreads();
    XcdBarrier bar = xcd_barrier_post((unsigned*)(args.ws + WS_BAR), (volatile LAS unsigned*)(F.lds + LDS_BYTES - 64), F.wave * 64 + fresh_lane());
#ifndef PROBE_DUP
#define PROBE_DUP 0
#endif
#define DUPN(k) ((PROBE_DUP >> (k)) & 1)
#define DUPB(k) for (int rep_ = 0; rep_ <= DUPN(k); ++rep_) {
#define DUPE(k) if (rep_ < DUPN(k)) xcd_barrier(bar, F.wave * 64 + fresh_lane()); }
#define IN(k) (lo <= (k) && (k) < hi)
#define SEAM(k) do { if (IN(k) && IN((k) + 1)) xcd_barrier(bar, F.wave * 64 + fresh_lane()); } while (0)
    unsigned char* ws = args.ws;
    if (IN(0)) { DUPB(0) REFRESH(F); phase_p0(F); __syncthreads(); DUPE(0) } SEAM(0);
    if (IN(1)) {
        DUPB(1)
        pg8::Gemm g{(const pg8::bf16_t*)(ws + WS_XB0), (const pg8::bf16_t*)(ws + WS_WGU1), MT, 2 * DFF, DM}; pg8::StaticOrder S; S.init(MT, 2 * DFF, F.G, F.bid);
        EpiSwiglu E{(bf16*)(ws + WS_ACT), (const float*)(ws + WS_SSQ0)};
        pg8::gemm_phase<EpiSwiglu, pg8::StaticOrder, true, true>(F.lds, g, S, E, F.wave * 64 + fresh_lane());
        REFRESH(F); convert_queue<1>(F, (unsigned*)(ws + WS_QCTR + 64), nullptr);
        DUPE(1)
    } SEAM(1);
    if (IN(2)) {
        DUPB(2)
        pg8::Gemm g{(const pg8::bf16_t*)(ws + WS_ACT), (const pg8::bf16_t*)(ws + WS_WD1), MT, DM, DFF}; SplitOrder S; S.init2(MT, DM, DFF, F.G, F.bid);
        EpiResid E{args.in[I_XP], args.in[I_XS], args.out + O_Y, (bf16*)(ws + WS_X1B), (float*)(ws + WS_SSQ1), 0.5f, (float*)(ws + WS_SLAB)};
        pg8::gemm_phase<EpiResid, SplitOrder, true, true>(F.lds, g, S, E, F.wave * 64 + fresh_lane());
        if (S.split) { xcd_barrier(bar, F.wave * 64 + fresh_lane()); REFRESH(F); resid_fixup(F, S, args.in[I_XP], args.in[I_XS], args.out + O_Y, (bf16*)(ws + WS_X1B), (float*)(ws + WS_SSQ1), 0.5f, (const float*)(ws + WS_SLAB)); }
        DUPE(2)
    } SEAM(2);
    if (IN(3)) {
        DUPB(3)
        pg8::Gemm g{(const pg8::bf16_t*)(ws + WS_X1B), (const pg8::bf16_t*)(ws + WS_WIN), MT, NINP, DM}; pg8::StaticOrder S; S.init(MT, NINP, F.G, F.bid);
        EpiInProj E{(bf16*)(ws + WS_P), (bf16*)(ws + WS_GATES), (float*)(ws + WS_GAGB), (const float*)(ws + WS_SSQ1), args.out + O_CONVP, args.out + O_CONVS};
        pg8::gemm_phase<EpiInProj, pg8::StaticOrder, true, true>(F.lds, g, S, E, F.wave * 64 + fresh_lane());
        DUPE(3)
    } SEAM(3);
#ifndef PROBE_AFLAGS
#define PROBE_AFLAGS -1
#endif
    if (IN(4)) { for (int rep_ = (PROBE_AFLAGS < 0 ? 1 : 0); rep_ < 2; ++rep_) { REFRESH(F); phase_a(F, rep_ == 0 ? (PROBE_AFLAGS & args.ph_hi) : 0); if (rep_ == 0) xcd_barrier(bar, F.wave * 64 + fresh_lane()); } } SEAM(4);
#ifndef PROBE_BFLAGS
#define PROBE_BFLAGS -1
#endif
    if (IN(5)) { for (int rep_ = (PROBE_BFLAGS < 0 ? 1 : 0); rep_ < 2; ++rep_) { REFRESH(F); phase_b(F, rep_ == 0 ? (PROBE_BFLAGS & args.ph_hi) : 0); if (rep_ == 0) xcd_barrier(bar, F.wave * 64 + fresh_lane()); } } SEAM(5);
#ifndef PROBE_CFLAGS
#define PROBE_CFLAGS -1
#endif
    if (IN(6)) { for (int rep_ = (PROBE_CFLAGS < 0 ? 1 : 0); rep_ < 2; ++rep_) { REFRESH(F); phase_c(F, rep_ == 0 ? (PROBE_CFLAGS & args.ph_hi) : 0); if (rep_ == 0) xcd_barrier(bar, F.wave * 64 + fresh_lane()); } } SEAM(6);
    if (IN(7)) {
        pg8::Gemm g{(const pg8::bf16_t*)(ws + WS_O), (const pg8::bf16_t*)(ws + WS_WOUT), MT, DM, DM}; SplitOrder S; S.init2(MT, DM, DM, F.G, F.bid);
        EpiResid E{args.out + O_Y, args.out + O_Y + (size_t)MP * DM, args.out + O_Y, (bf16*)(ws + WS_X2B), (float*)(ws + WS_SSQ2), 1.0f, (float*)(ws + WS_SLAB)};
        pg8::gemm_phase<EpiResid, SplitOrder, true, true>(F.lds, g, S, E, F.wave * 64 + fresh_lane());
        REFRESH(F); convert_queue<0>(F, (unsigned*)(ws + WS_QCTR), nullptr);
        if (S.split) { xcd_barrier(bar, F.wave * 64 + fresh_lane()); REFRESH(F); resid_fixup(F, S, args.out + O_Y, args.out + O_Y + (size_t)MP * DM, args.out + O_Y, (bf16*)(ws + WS_X2B), (float*)(ws + WS_SSQ2), 1.0f, (const float*)(ws + WS_SLAB)); }
    } SEAM(7);
    if (IN(8)) {
        DUPB(8)
        pg8::Gemm g{(const pg8::bf16_t*)(ws + WS_X2B), (const pg8::bf16_t*)(ws + WS_WGU2), MT, 2 * DFF, DM}; pg8::StaticOrder S; S.init(MT, 2 * DFF, F.G, F.bid);
        EpiSwiglu E{(bf16*)(ws + WS_ACT), (const float*)(ws + WS_SSQ2)};
        pg8::gemm_phase<EpiSwiglu, pg8::StaticOrder, true, true>(F.lds, g, S, E, F.wave * 64 + fresh_lane());
        DUPE(8)
    } SEAM(8);
    if (IN(9)) {
        pg8::Gemm g{(const pg8::bf16_t*)(ws + WS_ACT), (const pg8::bf16_t*)(ws + WS_WD2), MT, DM, DFF}; SplitOrder S; S.init2(MT, DM, DFF, F.G, F.bid);
        EpiResid E{args.out + O_Y, args.out + O_Y + (size_t)MP * DM, args.out + O_Y, nullptr, (float*)(ws + WS_SSQ3), 0.5f, (float*)(ws + WS_SLAB)};
        pg8::gemm_phase<EpiResid, SplitOrder, true, true>(F.lds, g, S, E, F.wave * 64 + fresh_lane());
    } SEAM(9);
    if (IN(10)) { REFRESH(F); SplitOrder S; S.init2(MT, DM, DFF, F.G, F.bid); phase_final(F, S); }
#undef IN
#undef SEAM
}

extern "C" void kernel_launch(void* const* d_in, const int* in_sizes, int n_in, void* d_out, int out_size, void* d_ws, size_t ws_size, hipStream_t stream) {
    static int grid = 0;
    if (grid == 0) {
        if (n_in != 22 || (size_t)out_size != O_END || ws_size < WS_END) { fprintf(stderr, "kernel_launch: unexpected shapes: n_in %d out %d (want %zu) ws %zu (need %zu)\n", n_in, out_size, (size_t)O_END, ws_size, (size_t)WS_END); grid = -1; return; }
        int dev = 0, cus = 0, per_cu = 0;
        hipGetDevice(&dev); hipDeviceGetAttribute(&cus, hipDeviceAttributeMultiprocessorCount, dev);
        hipFuncSetAttribute((const void*)mixer_fwd, hipFuncAttributeMaxDynamicSharedMemorySize, LDS_BYTES);
        hipOccupancyMaxActiveBlocksPerMultiprocessor(&per_cu, (const void*)mixer_fwd, NTHR, LDS_BYTES);
        if (per_cu < 1) { fprintf(stderr, "kernel_launch: occupancy query says %d blocks/CU\n", per_cu); grid = -1; return; }
        grid = cus;
    }
    if (grid < 0) return;
    Args a{};
    for (int i = 0; i < 22; ++i) a.in[i] = (const float*)d_in[i];
    a.out = (float*)d_out; a.ws = (unsigned char*)d_ws; a.ph_lo = 0; a.ph_hi = 11;
    if (hipMemsetAsync((char*)d_ws + WS_BAR, 0, 16384 + 256, stream) != hipSuccess) { fprintf(stderr, "kernel_launch: memset failed\n"); return; }
    hipLaunchKernelGGL(mixer_fwd, dim3(grid), dim3(NTHR), LDS_BYTES, stream, a);
    hipError_t e = hipPeekAtLastError();
    if (e != hipSuccess) fprintf(stderr, "launch failed: %s (grid %d)\n", hipGetErrorString(e), grid);
}
```

```cpp
#include <hip/hip_runtime.h>
#include <cstdio>
#include <cstdint>
namespace pg8 {
#define PG8_LAS __attribute__((address_space(3)))
typedef unsigned short bf16_t;
typedef short bf16x8 __attribute__((ext_vector_type(8)));
typedef float f32x4 __attribute__((ext_vector_type(4)));
typedef unsigned u32x4 __attribute__((ext_vector_type(4)));
constexpr int BM = 256, BK = 64, HALF = 128, HTB = HALF * BK * 2  , STAGE_BYTES = 8 * HTB, NXCD = 8, WGM = 6;

__host__ __device__ __forceinline__ int lds_byte(int r, int c) { const int st = (r >> 4) * 2 + (c >> 5), rr = r & 15, cc = c & 31, ob = rr * 64 + cc * 2; return st * 1024 + (ob ^ (((ob >> 9) & 1) << 5)); }
__host__ __device__ __forceinline__ void stage_rc(int b, int& R, int& C) { const int st = b / 1024, sb = b % 1024, swz = sb ^ (((sb >> 9) & 1) << 5); R = (st >> 1) * 16 + swz / 64; C = (st & 1) * 32 + (swz % 64) / 2; }
__host__ __device__ __forceinline__ int perm32(int rho) { const int n = rho >> 4, i = rho & 15; return 8 * (i >> 2) + 4 * n + (i & 3); }

struct Unit { int pm, pn, k0, nt, part; };
struct Gemm { const bf16_t* A; const bf16_t* Bt; int M, N, K; };

struct StaticOrder {
    int nM, nN, nwg, G, c;
    __host__ __device__ void init(int M, int N, int G_, int c_) { nM = M / BM; nN = N / BM; nwg = nM * nN; G = G_; c = c_; }
    __host__ __device__ __forceinline__ bool next(int i, Unit& u) const { return tile((long)i * G + c, u); }
    __host__ __device__ __forceinline__ bool tile(long L, Unit& u) const {
        u.k0 = 0; u.nt = 0; u.part = 0;
        if (L >= nwg) return false;
        int wgid = (int)L; { const int q = nwg / NXCD, r = nwg % NXCD, xcd = wgid % NXCD, off = wgid / NXCD; wgid = (xcd < r ? xcd * (q + 1) : r * (q + 1) + (xcd - r) * q) + off; }
        const int nig = WGM * nN, gid = wgid / nig, fm = gid * WGM, gsz = (nM - fm) < WGM ? (nM - fm) : WGM;
        u.pm = fm + ((wgid % nig) % gsz); u.pn = (wgid % nig) / gsz; return true;
    }
    __device__ __forceinline__ void a_ready(const Unit&) const {}
    __device__ __forceinline__ void done(const Unit&) const {}
};

__device__ __forceinline__ unsigned cvt_pk_bf16(float lo, float hi) { unsigned r; asm volatile("v_cvt_pk_bf16_f32 %0, %1, %2" : "=v"(r) : "v"(lo), "v"(hi)); return r; }
typedef float f32x2 __attribute__((ext_vector_type(2)));
template <class Epi, class Sched, bool ALIGN_EPI = false, bool SP2 = false>
__device__ __forceinline__ void gemm_phase(PG8_LAS unsigned char* lds, const Gemm g, const Sched& S, const Epi& E, const int tid_in) {
    const int tid = tid_in, wid = __builtin_amdgcn_readfirstlane(tid >> 6), lane = tid & 63, wr = wid >> 2, wc = wid & 3, fr = lane & 15, fq = lane >> 4;
    const int K = g.K, nt = K / BK;
    unsigned voffA[2], voffB[2];
#pragma unroll
    for (int i = 0; i < 2; ++i) { int R, C; stage_rc(tid * 16 + i * 8192, R, C); const int Rb = Epi::PERM ? ((R & ~31) + perm32(R & 31)) : R;
        voffA[i] = (unsigned)(R * K + C) * 2u; voffB[i] = (unsigned)(Rb * K + C) * 2u; }
    const size_t kstep = (size_t)(BK * 2);
    const size_t hstep = (size_t)HALF * K * 2;
    const size_t tstep = 2 * hstep;
    const unsigned ldsw = (unsigned)wid * 1024u;
    const int aoff = lds_byte(wr * 64 + fr, fq * 8), boff = lds_byte(wc * 32 + fr, fq * 8);
#define PG8_SA(b, h) (((b) * 2 + (h)) * HTB)
#define PG8_SB(b, h) ((4 + (b) * 2 + (h)) * HTB)
#define PG8_STAGE(bufoff, gbase, voff) do { _Pragma("unroll") for (int _i = 0; _i < 2; ++_i) \
        __builtin_amdgcn_global_load_lds((const unsigned*)((const char*)(gbase) + (voff)[_i]), (PG8_LAS unsigned*)(lds + (bufoff) + ldsw + _i * 8192), 16, 0, 0); } while (0)
#define PG8_LDA(dst, b, h) do { _Pragma("unroll") for (int m = 0; m < 4; ++m) _Pragma("unroll") for (int k = 0; k < 2; ++k) dst[m][k] = *(const PG8_LAS bf16x8*)(lds + PG8_SA(b, h) + aoff + m * 2048 + k * 1024); } while (0)
#define PG8_LDB(dst, b, h) do { _Pragma("unroll") for (int n = 0; n < 2; ++n) _Pragma("unroll") for (int k = 0; k < 2; ++k) dst[n][k] = *(const PG8_LAS bf16x8*)(lds + PG8_SB(b, h) + boff + n * 2048 + k * 1024); } while (0)
#define PG8_MMA(ai, bj, At, Bt) do { __builtin_amdgcn_s_setprio(1); _Pragma("unroll") for (int m = 0; m < 4; ++m) _Pragma("unroll") for (int n = 0; n < 2; ++n) _Pragma("unroll") for (int k = 0; k < 2; ++k) \
        acc[ai][bj][m][n] = __builtin_amdgcn_mfma_f32_16x16x32_bf16(Bt[n][k], At[m][k], acc[ai][bj][m][n], 0, 0, 0); __builtin_amdgcn_s_setprio(0); } while (0)
#define PG8_WAIT_V(n) asm volatile("s_waitcnt vmcnt(" #n ")" ::: "memory")
#define PG8_WAIT_L(n) asm volatile("s_waitcnt lgkmcnt(" #n ")" ::: "memory")
#define PG8_BAR __builtin_amdgcn_s_barrier()
#define PG8_SCHED __builtin_amdgcn_sched_barrier(0)
    Unit cur, nxt; int ui = 0;
    if (!S.next(0, cur)) return;
    f32x4 acc[2][2][4][2];
#pragma unroll
    for (int a = 0; a < 2; ++a)
#pragma unroll
        for (int b = 0; b < 2; ++b)
#pragma unroll
            for (int m = 0; m < 4; ++m)
#pragma unroll
                for (int n = 0; n < 2; ++n) acc[a][b][m][n] = (f32x4){0.f, 0.f, 0.f, 0.f};
    bf16x8 At[4][2], B0[2][2], B1[2][2];
    const char* cA = (const char*)g.A + (size_t)cur.pm * tstep + (size_t)cur.k0 * kstep; const char* cB = (const char*)g.Bt + (size_t)cur.pn * tstep + (size_t)cur.k0 * kstep;
    S.a_ready(cur);
    if constexpr (SP2) {
        PG8_STAGE(PG8_SB(0, 0), cB, voffB); PG8_STAGE(PG8_SB(0, 1), cB + hstep, voffB); PG8_STAGE(PG8_SA(0, 0), cA, voffA); PG8_STAGE(PG8_SA(0, 1), cA + hstep, voffA);
        if (wr == 1) PG8_BAR;
        PG8_WAIT_V(2); PG8_BAR;
        PG8_STAGE(PG8_SB(1, 0), cB + kstep, voffB); PG8_STAGE(PG8_SA(1, 0), cA + kstep, voffA); PG8_STAGE(PG8_SB(1, 1), cB + hstep + kstep, voffB);
        PG8_WAIT_V(6); PG8_BAR;
    } else {
        PG8_STAGE(PG8_SB(0, 0), cB, voffB); PG8_STAGE(PG8_SA(0, 0), cA, voffA); PG8_STAGE(PG8_SB(0, 1), cB + hstep, voffB); PG8_STAGE(PG8_SA(0, 1), cA + hstep, voffA);
        if (wr == 1) PG8_BAR;
        PG8_WAIT_V(4); PG8_BAR;
        PG8_STAGE(PG8_SB(1, 0), cB + kstep, voffB); PG8_STAGE(PG8_SA(1, 0), cA + kstep, voffA); PG8_STAGE(PG8_SB(1, 1), cB + hstep + kstep, voffB);
        PG8_WAIT_V(6); PG8_BAR;
    }
    for (;;) {
        const bool has_next = S.next(ui + 1, nxt);
        const char* nA = has_next ? (const char*)g.A + (size_t)nxt.pm * tstep + (size_t)nxt.k0 * kstep : cA; const char* nB = has_next ? (const char*)g.Bt + (size_t)nxt.pn * tstep + (size_t)nxt.k0 * kstep : cB;
        const int cnt = cur.nt ? cur.nt : nt;
        for (int t = 0; t < cnt; t += 2) {
            const bool last = (t == cnt - 2);
            const char* a1 = cA + (size_t)(t + 1) * kstep;
            const char* a2 = last ? nA : cA + (size_t)(t + 2) * kstep; const char* b2 = last ? nB : cB + (size_t)(t + 2) * kstep;
            const char* a3 = a2 + kstep; const char* b3 = b2 + kstep;
            if (last && has_next) S.a_ready(nxt);
            if constexpr (SP2) {
            PG8_LDB(B0, 0, 0); PG8_LDB(B1, 0, 1); PG8_SCHED; PG8_LDA(At, 0, 0); PG8_STAGE(PG8_SA(1, 1), a1 + hstep, voffA);
            PG8_WAIT_V(8); PG8_WAIT_L(0); PG8_BAR; PG8_MMA(0, 0, At, B0); PG8_MMA(0, 1, At, B1); PG8_BAR; PG8_SCHED;
            PG8_LDA(At, 0, 1); PG8_STAGE(PG8_SB(0, 0), b2, voffB); PG8_STAGE(PG8_SB(0, 1), b2 + hstep, voffB); PG8_STAGE(PG8_SA(0, 0), a2, voffA);
            PG8_WAIT_V(8); PG8_WAIT_L(0); PG8_BAR; PG8_MMA(1, 0, At, B0); PG8_MMA(1, 1, At, B1); PG8_BAR; PG8_SCHED;
            PG8_LDB(B0, 1, 0); PG8_LDB(B1, 1, 1); PG8_SCHED; PG8_LDA(At, 1, 0); PG8_STAGE(PG8_SA(0, 1), a2 + hstep, voffA);
            PG8_WAIT_V(8); PG8_WAIT_L(0); PG8_BAR; PG8_MMA(0, 0, At, B0); PG8_MMA(0, 1, At, B1); PG8_BAR; PG8_SCHED;
            PG8_LDA(At, 1, 1); PG8_STAGE(PG8_SB(1, 0), b3, voffB); PG8_STAGE(PG8_SB(1, 1), b3 + hstep, voffB); PG8_STAGE(PG8_SA(1, 0), a3, voffA);
            PG8_WAIT_V(8); PG8_WAIT_L(0); PG8_BAR; PG8_MMA(1, 0, At, B0); PG8_MMA(1, 1, At, B1); PG8_BAR; PG8_SCHED;
            } else {
            PG8_LDB(B0, 0, 0); PG8_SCHED; PG8_LDA(At, 0, 0); PG8_STAGE(PG8_SA(1, 1), a1 + hstep, voffA);
            PG8_WAIT_L(8); PG8_BAR; PG8_WAIT_L(0); PG8_MMA(0, 0, At, B0); PG8_BAR; PG8_SCHED;
            PG8_LDB(B1, 0, 1); PG8_STAGE(PG8_SB(0, 0), b2, voffB);
            PG8_BAR; PG8_WAIT_L(0); PG8_MMA(0, 1, At, B1); PG8_BAR;
            PG8_LDA(At, 0, 1); PG8_STAGE(PG8_SA(0, 0), a2, voffA);
            PG8_BAR; PG8_WAIT_L(0); PG8_MMA(1, 0, At, B0); PG8_BAR; PG8_SCHED;
            PG8_STAGE(PG8_SB(0, 1), b2 + hstep, voffB);
            PG8_WAIT_V(6); PG8_BAR; PG8_MMA(1, 1, At, B1); PG8_BAR;
            PG8_LDB(B0, 1, 0); PG8_SCHED; PG8_LDA(At, 1, 0); PG8_STAGE(PG8_SA(0, 1), a2 + hstep, voffA);
            PG8_WAIT_L(8); PG8_BAR; PG8_WAIT_L(0); PG8_MMA(0, 0, At, B0); PG8_BAR; PG8_SCHED;
            PG8_LDB(B1, 1, 1); PG8_STAGE(PG8_SB(1, 0), b3, voffB);
            PG8_BAR; PG8_WAIT_L(0); PG8_MMA(0, 1, At, B1); PG8_BAR;
            PG8_LDA(At, 1, 1); PG8_STAGE(PG8_SA(1, 0), a3, voffA);
            PG8_BAR; PG8_WAIT_L(0); PG8_MMA(1, 0, At, B0); PG8_BAR; PG8_SCHED;
            PG8_STAGE(PG8_SB(1, 1), b3 + hstep, voffB);
            PG8_WAIT_V(6); PG8_BAR; PG8_MMA(1, 1, At, B1); PG8_BAR;
            }
        }
        if constexpr (ALIGN_EPI) { if (wr == 0) PG8_BAR; }
        if constexpr (!Epi::AFTER_DRAIN) { E(acc, cur, wr, wc, fr, fq); S.done(cur); }
        if (!has_next) break;
#pragma unroll
        for (int a = 0; a < 2; ++a)
#pragma unroll
            for (int b = 0; b < 2; ++b)
#pragma unroll
                for (int m = 0; m < 4; ++m)
#pragma unroll
                    for (int n = 0; n < 2; ++n) acc[a][b][m][n] = (f32x4){0.f, 0.f, 0.f, 0.f};
        cur = nxt; cA = nA; cB = nB; ++ui;
        if constexpr (ALIGN_EPI) { if (wr == 1) PG8_BAR; }
    }
    PG8_WAIT_V(0);
    if constexpr (!ALIGN_EPI) { if (wr == 0) PG8_BAR; }
    PG8_BAR;
    if constexpr (Epi::AFTER_DRAIN) { E.fused(acc, cur, wr, wc, fr, fq, lds, wid, lane); S.done(cur); }
#undef PG8_SA
#undef PG8_SB
#undef PG8_STAGE
#undef PG8_LDA
#undef PG8_LDB
#undef PG8_MMA
#undef PG8_WAIT_V
#undef PG8_WAIT_L
#undef PG8_BAR
#undef PG8_SCHED
}
}

#define GAS __attribute__((address_space(1)))
#define LAS __attribute__((address_space(3)))
typedef unsigned short bf16;
typedef unsigned u32x4 __attribute__((ext_vector_type(4)));
typedef unsigned u32x2 __attribute__((ext_vector_type(2)));
typedef float f32x4 __attribute__((ext_vector_type(4)));
typedef short bf16x8 __attribute__((ext_vector_type(8)));

constexpr int NTHR = 512, NWAVES = 8;
constexpr int DM = 2048, DFF = 5632, MP = 8192, MS = 1024, MT = MP + MS;
constexpr int NIN = 8208, NINP = 8448;
constexpr int NCH = 144;
constexpr int NITEM = 8 * NCH;
constexpr float EPS = 1e-6f;
constexpr int PW = 6144;
constexpr int LDS_BYTES = 147456;

constexpr size_t O_Y = 0;
constexpr size_t O_RETP = (size_t)MT * DM;
constexpr size_t O_GDNP = O_RETP + 8 * 16384;
constexpr size_t O_CONVP = O_GDNP + 8 * 16384;
constexpr size_t O_RETS = O_CONVP + 3 * 3072;
constexpr size_t O_GDNS = O_RETS + (size_t)16 * 8 * 16384;
constexpr size_t O_CONVS = O_GDNS + (size_t)16 * 8 * 16384;
constexpr size_t O_END = O_CONVS + (size_t)16 * 3 * 3072;

constexpr size_t SSQ_BYTES = (size_t)MT * 32 * 4;
constexpr size_t WS_SSQ0 = 0, WS_SSQ1 = WS_SSQ0 + SSQ_BYTES, WS_SSQ2 = WS_SSQ1 + SSQ_BYTES, WS_SSQ3 = WS_SSQ2 + SSQ_BYTES;
constexpr size_t WS_GAGB = WS_SSQ3 + SSQ_BYTES;
constexpr size_t WS_CDG = WS_GAGB + (size_t)MT * 16 * 4;
constexpr int XCD_BAR_WORDS_C = 3456;
constexpr size_t WS_BAR = 5767168;
constexpr size_t WS_R1 = 6u << 20;
static_assert(WS_CDG + NITEM * 4 <= WS_BAR && XCD_BAR_WORDS_C * 4 <= 16384 && WS_BAR + 16384 + 256 <= (6u << 20), "map");

constexpr size_t SZ_WGU = (size_t)2 * DFF * DM * 2, SZ_WD = (size_t)DM * DFF * 2, SZ_WIN = (size_t)NINP * DM * 2, SZ_WOUT = (size_t)DM * DM * 2;
constexpr size_t WS_WGU1 = WS_R1, WS_WD1 = WS_WGU1 + SZ_WGU, WS_WIN = WS_WD1 + SZ_WD, WS_WOUT = WS_WIN + SZ_WIN;
constexpr size_t SZ_ACT16 = (size_t)MT * DM * 2;
constexpr size_t WS_X1B = WS_WGU1;
static_assert(SZ_ACT16 <= SZ_WGU, "overlay");
constexpr size_t WS_R2 = WS_WOUT + SZ_WOUT;
constexpr size_t SZ_P = (size_t)MT * PW * 2;
constexpr size_t WS_P = WS_R2, WS_GATES = WS_P + SZ_P;
constexpr size_t WS_ACT = WS_R2, WS_XB0 = WS_ACT + (size_t)MT * DFF * 2;
static_assert(WS_XB0 + SZ_ACT16 <= WS_GATES + SZ_ACT16, "overlay");
constexpr size_t FR16 = 16384, FR8 = 8192;
constexpr size_t WS_SP = WS_R2;
constexpr size_t WS_DL = WS_SP + (size_t)2 * NITEM * 32768;
static_assert(WS_DL + (size_t)NITEM * FR16 <= WS_GATES, "overlay");
constexpr size_t WS_R3 = WS_GATES + SZ_ACT16;
constexpr size_t WS_NW = WS_R3, WS_KDG = WS_NW + NITEM * FR16, WS_QDG = WS_KDG + NITEM * FR16, WS_UG = WS_QDG + NITEM * FR16, WS_QKG = WS_UG + NITEM * FR16;
constexpr size_t WS_KDR = WS_QKG + NITEM * FR8, WS_QDR = WS_KDR + NITEM * FR16, WS_VR = WS_QDR + NITEM * FR16, WS_SCR = WS_VR + NITEM * FR16;
constexpr size_t WS_R3END = WS_SCR + NITEM * FR8;
constexpr size_t WS_X2B = WS_R3;
constexpr size_t WS_WGU2 = WS_WGU1;
constexpr size_t WS_WD2 = WS_R3END;
constexpr size_t WS_O = WS_WD1;
static_assert(WS_O + SZ_ACT16 <= WS_WOUT, "overlay");
constexpr size_t WS_SLAB = WS_R3 + (40u << 20);
static_assert(WS_SLAB + (size_t)256 * 65536 * 4 <= WS_R3END, "map");
constexpr size_t WS_END = WS_WD2 + SZ_WD;
constexpr size_t WS_QCTR = WS_BAR + 16384;

struct Args {
    const float* in[22];
    float* out; unsigned char* ws;
    int ph_lo, ph_hi;
};
enum { I_XP = 0, I_XS, I_SRET, I_SGDN, I_SCONV, I_F1N, I_F1G, I_F1U, I_F1D, I_MIXN, I_WIN, I_RETN, I_CONVW, I_ALOG, I_DTB, I_GDNN, I_WOUT, I_F2N, I_F2G, I_F2U, I_F2D, I_FINN };

typedef float f32x2 __attribute__((ext_vector_type(2)));
typedef __bf16 bf16x2v __attribute__((ext_vector_type(2)));
__device__ __forceinline__ unsigned pk2(float lo, float hi) { const f32x2 v = {lo, hi}; return __builtin_bit_cast(unsigned, __builtin_convertvector(v, bf16x2v)); }
__device__ __forceinline__ unsigned f2bf(float f) { return pk2(f, 0.f) & 0xffffu; }
__device__ __forceinline__ float bf2f(unsigned short b) { return __builtin_bit_cast(float, (unsigned)b << 16); }
__device__ __forceinline__ float silu_f(float g) { return g * __builtin_amdgcn_rcpf(1.f + __expf(-g)); }
__device__ __forceinline__ float wave_sum(float v) {
#pragma unroll
    for (int o = 1; o < 64; o <<= 1) v += __shfl_xor(v, o);
    return v;
}
__device__ __forceinline__ float row_rinv(const float* ssq, int row, int fq) {
    const f32x4* p = (const f32x4*)(ssq + (size_t)row * 32 + fq * 8);
    const f32x4 a = p[0], b = p[1];
    float s = ((a[0] + a[1]) + (a[2] + a[3])) + ((b[0] + b[1]) + (b[2] + b[3]));
    s += __shfl_xor(s, 16); s += __shfl_xor(s, 32);
    return rsqrtf(s * (1.f / DM) + EPS);
}

__device__ __forceinline__ int fresh_lane() { int l = __builtin_amdgcn_mbcnt_hi(~0u, __builtin_amdgcn_mbcnt_lo(~0u, 0u)); asm volatile("" : "+v"(l)); return l; }
#define REFRESH(F) do { (F).lane = fresh_lane(); (F).tid = (F).wave * 64 + (F).lane; } while (0)
using pg8::Unit;
struct EpiSwiglu {
    static constexpr bool PERM = true, AFTER_DRAIN = false;
    bf16* O; const float* ssq;
    __device__ __forceinline__ void operator()(const f32x4 (&acc)[2][2][4][2], const Unit& u, int wr, int wc, int fr, int fq) const {
        const int row0 = u.pm * 256 + wr * 64 + fr, col0 = u.pn * 128 + wc * 32 + 8 * fq;
        float rr[2][4];
#pragma unroll
        for (int ai = 0; ai < 2; ++ai)
#pragma unroll
            for (int m = 0; m < 4; ++m) rr[ai][m] = row_rinv(ssq, row0 + ai * 128 + m * 16, fq);
#pragma unroll
        for (int ai = 0; ai < 2; ++ai)
#pragma unroll
            for (int m = 0; m < 4; ++m) {
                const int row = row0 + ai * 128 + m * 16; const float r = rr[ai][m];
                float h[8];
#pragma unroll
                for (int n = 0; n < 2; ++n)
#pragma unroll
                    for (int k = 0; k < 4; ++k) { const float g = acc[ai][0][m][n][k] * r, up = acc[ai][1][m][n][k] * r; h[n * 4 + k] = silu_f(g) * up; }
                u32x4 w; w.x = pg8::cvt_pk_bf16(h[0], h[1]); w.y = pg8::cvt_pk_bf16(h[2], h[3]); w.z = pg8::cvt_pk_bf16(h[4], h[5]); w.w = pg8::cvt_pk_bf16(h[6], h[7]);
                *(u32x4*)(O + (size_t)row * DFF + col0) = w;
            }
    }
};
struct SplitOrder : pg8::StaticOrder {
    int ntq; bool split;
    __device__ __forceinline__ void init2(int M, int N, int K, int G_, int c_) { init(M, N, G_, c_); ntq = K / 64 / 4; split = (nwg > G) && (4 * (nwg - G) <= G) && (ntq >= 4) && !(ntq & 1) && (ntq * 4 * 64 == K); }
    __device__ __forceinline__ bool next(int i, Unit& u) const {
        if (!split) return pg8::StaticOrder::next(i, u);
        if (i == 0) return tile(c, u);
        if (i == 1 && (c >> 2) < nwg - G) { tile(G + (c >> 2), u); u.k0 = (c & 3) * ntq; u.nt = ntq; u.part = 1 + c; return true; }
        return false;
    }
};
struct EpiResid {
    static constexpr bool PERM = false, AFTER_DRAIN = false;
    const float* resp; const float* ress; float* out; bf16* outb; float* ssq; float scale; float* slab;
    __device__ __forceinline__ void operator()(const f32x4 (&acc)[2][2][4][2], const Unit& u, int wr, int wc, int fr, int fq) const {
        if (u.part) {
            float* sb = slab + (size_t)(u.part - 1) * 65536 + (wr * 64 + fr) * 256 + wc * 32 + 4 * fq;
#pragma unroll
            for (int ai = 0; ai < 2; ++ai)
#pragma unroll
                for (int m = 0; m < 4; ++m)
#pragma unroll
                    for (int bj = 0; bj < 2; ++bj)
#pragma unroll
                        for (int n = 0; n < 2; ++n) *(f32x4*)(sb + (ai * 128 + m * 16) * 256 + bj * 128 + n * 16) = acc[ai][bj][m][n];
            return;
        }
        const int col0 = u.pn * 256 + wc * 32 + 4 * fq;
        f32x4 res[2][2][2], resn[2][2][2];
#define RES_LOAD(dst, am_) do { const int ai_ = (am_) >> 1, m0_ = ((am_) & 1) * 2; \
            _Pragma("unroll") for (int mm = 0; mm < 2; ++mm) { const int row_ = u.pm * 256 + ai_ * 128 + wr * 64 + (m0_ + mm) * 16 + fr; \
                const float* rb_ = (row_ < MP) ? resp + (size_t)row_ * DM : ress + (size_t)(row_ - MP) * DM; \
                _Pragma("unroll") for (int bj = 0; bj < 2; ++bj) _Pragma("unroll") for (int n = 0; n < 2; ++n) dst[mm][bj][n] = *(const f32x4*)(rb_ + col0 + bj * 128 + n * 16); } } while (0)
        RES_LOAD(res, 0);
#pragma unroll
        for (int am = 0; am < 4; ++am) {
            const int ai = am >> 1, m0 = (am & 1) * 2;
            if (am < 3) RES_LOAD(resn, am + 1);
#pragma unroll
            for (int mm = 0; mm < 2; ++mm) {
                const int m = m0 + mm;
                const int row = u.pm * 256 + ai * 128 + wr * 64 + m * 16 + fr;
                float ss = 0.f;
#pragma unroll
                for (int bj = 0; bj < 2; ++bj)
#pragma unroll
                    for (int n = 0; n < 2; ++n) {
                        const int col = col0 + bj * 128 + n * 16;
                        const f32x4 v = res[mm][bj][n] + acc[ai][bj][m][n] * scale;
                        *(f32x4*)(out + (size_t)row * DM + col) = v;
                        ss += (v[0] * v[0] + v[1] * v[1]) + (v[2] * v[2] + v[3] * v[3]);
                        if (outb) { u32x2 w; w.x = pg8::cvt_pk_bf16(v[0], v[1]); w.y = pg8::cvt_pk_bf16(v[2], v[3]); *(u32x2*)(outb + (size_t)row * DM + col) = w; }
                    }
                ss += __shfl_xor(ss, 16); ss += __shfl_xor(ss, 32);
                if (fq == 0) ssq[(size_t)row * 32 + u.pn * 4 + wc] = ss;
            }
#pragma unroll
            for (int mm = 0; mm < 2; ++mm)
#pragma unroll
                for (int bj = 0; bj < 2; ++bj)
#pragma unroll
                    for (int n = 0; n < 2; ++n) res[mm][bj][n] = resn[mm][bj][n];
        }
#undef RES_LOAD
    }
};
struct EpiInProj {
    static constexpr bool PERM = true, AFTER_DRAIN = false;
    bf16* P; bf16* GATES; float* GAGB; const float* ssq; float* convp; float* convs;
    __device__ __forceinline__ void operator()(const f32x4 (&acc)[2][2][4][2], const Unit& u, int wr, int wc, int fr, int fq) const {
        const int pn = u.pn;
        const bool gate = (pn >= 12 && pn < 16) || (pn >= 28 && pn < 32);
        const bool convt = (pn >= 16 && pn < 28);
        float rr[2][4];
#pragma unroll
        for (int ai = 0; ai < 2; ++ai)
#pragma unroll
            for (int m = 0; m < 4; ++m) rr[ai][m] = row_rinv(ssq, u.pm * 256 + ai * 128 + wr * 64 + m * 16 + fr, fq);
#pragma unroll
        for (int ai = 0; ai < 2; ++ai)
#pragma unroll
            for (int m = 0; m < 4; ++m) {
                const int row = u.pm * 256 + ai * 128 + wr * 64 + m * 16 + fr; const float r = rr[ai][m];
                if (pn == 32) {
                    if (wc == 0 && fq < 2) {
#pragma unroll
                        for (int n = 0; n < 2; ++n) *(f32x4*)(GAGB + (size_t)row * 16 + 8 * fq + 4 * n) = acc[ai][0][m][n] * r;
                    }
                } else {
                    bf16* dst;
                    if (pn < 12) dst = P + (size_t)row * PW + 256 * pn;
                    else if (pn < 16) dst = GATES + (size_t)row * 2048 + 256 * (pn - 12);
                    else if (pn < 28) dst = P + (size_t)row * PW + 3072 + 256 * (pn - 16);
                    else dst = GATES + (size_t)row * 2048 + 1024 + 256 * (pn - 28);
                    const bool crow = convt && ((row & 63) >= 61) && (row >= MP - 3);
#pragma unroll
                    for (int bj = 0; bj < 2; ++bj) {
                        f32x4 v0 = acc[ai][bj][m][0] * r, v1 = acc[ai][bj][m][1] * r;
                        if (crow) {
                            const int i = (row & 63) - 61, ch = 256 * (pn - 16) + bj * 128 + wc * 32 + 8 * fq;
                            float* cd = (row < MP) ? convp + (size_t)i * 3072 + ch : convs + ((size_t)((row - MP) >> 6) * 3 + i) * 3072 + ch;
                            *(f32x4*)cd = v0; *(f32x4*)(cd + 4) = v1;
                        }
                        if (gate) {
#pragma unroll
                            for (int k = 0; k < 4; ++k) { v0[k] = silu_f(v0[k]); v1[k] = silu_f(v1[k]); }
                        }
                        u32x4 w; w.x = pg8::cvt_pk_bf16(v0[0], v0[1]); w.y = pg8::cvt_pk_bf16(v0[2], v0[3]); w.z = pg8::cvt_pk_bf16(v1[0], v1[1]); w.w = pg8::cvt_pk_bf16(v1[2], v1[3]);
                        *(u32x4*)(dst + bj * 128 + wc * 32 + 8 * fq) = w;
                    }
                }
            }
    }
};

#define XB_TMO      128
#define XB_XCNT(j)  (256  + 64 * (j))
#define XB_XSUB(j)  (1280 + 64 * (j))
#define XB_XGEN(j)  (2304 + 64 * (j))
#define XB_TOP      3328
#define XB_TOPGEN   3392
#define XCD_BAR_WORDS 3456
#define XB_SPIN_CAP (1u << 18)

__device__ __forceinline__ unsigned xb_ld(unsigned* p)              { return __hip_atomic_load(p, __ATOMIC_RELAXED, __HIP_MEMORY_SCOPE_AGENT); }
__device__ __forceinline__ unsigned xb_add(unsigned* p, unsigned v) { return __hip_atomic_fetch_add(p, v, __ATOMIC_RELAXED, __HIP_MEMORY_SCOPE_AGENT); }
__device__ __forceinline__ unsigned xb_xcc_id() { return (unsigned)__builtin_amdgcn_s_getreg((3 << 11) | 20) & 0xFu; }
#define XB_SPIN(cond, bar) do { unsigned _sp = 0; while (cond) { __builtin_amdgcn_s_sleep(1); \
    if ((++_sp & 255u) == 0u) { if (xb_ld(&(bar)[XB_TMO])) break; if (_sp > XB_SPIN_CAP) { atomicAdd(&(bar)[XB_TMO], 1u); break; } } } } while (0)

struct XcdBarrier {
    unsigned* bar; unsigned x;
    volatile LAS unsigned* st;
};

__device__ __forceinline__ XcdBarrier xcd_barrier_post(unsigned* bar, volatile LAS unsigned* st, int tid) {
    XcdBarrier b; b.bar = bar; b.x = xb_xcc_id(); b.st = st;
    if (tid == 0) (void)xb_add(&bar[XB_XCNT(b.x)], 1u);
    return b;
}
__device__ __forceinline__ void xcd_barrier_complete(unsigned* bar, unsigned x, unsigned& nloc, unsigned& nx) {
    const unsigned G = gridDim.x * gridDim.y * gridDim.z;
    unsigned sum, cnt, mine, sp = 0u;
    for (;;) {
        sum = 0u; cnt = 0u; mine = 0u;
#pragma unroll
        for (unsigned j = 0; j < 16; ++j) { const unsigned c = xb_ld(&bar[XB_XCNT(j)]); sum += c; cnt += (c > 0u) ? 1u : 0u; mine = (j == x) ? c : mine; }
        if (sum == G) break;
        __builtin_amdgcn_s_sleep(1);
        if ((++sp & 255u) == 0u) { if (xb_ld(&bar[XB_TMO])) break; if (sp > XB_SPIN_CAP) { atomicAdd(&bar[XB_TMO], 1u); break; } }
    }
    nloc = mine > 0u ? mine : 1u; nx = cnt > 0u ? cnt : 1u;
}

__device__ __forceinline__ void xcd_barrier(const XcdBarrier& b, int tid) {
    asm volatile("s_waitcnt vmcnt(0)" ::: "memory");
    __syncthreads();
    if (tid == 0) {
        unsigned* bar = b.bar;
        __builtin_amdgcn_s_waitcnt(0);
        unsigned nloc = b.st[0], nx = b.st[1];
        if (nloc == 0u) { xcd_barrier_complete(bar, b.x, nloc, nx); b.st[0] = nloc; b.st[1] = nx; }
        const unsigned old = xb_add(&bar[XB_XSUB(b.x)], 1u);
        const unsigned gen = old / nloc;
        if (old + 1u == (gen + 1u) * nloc) {
            __builtin_amdgcn_fence(__ATOMIC_RELEASE, "agent");
            asm volatile("s_waitcnt vmcnt(0)" ::: "memory");
            const unsigned og = xb_add(&bar[XB_TOP], 1u);
            const unsigned tg = og / nx;
            if (og + 1u == (tg + 1u) * nx) xb_add(&bar[XB_TOPGEN], 1u);
            else XB_SPIN(xb_ld(&bar[XB_TOPGEN]) == tg, bar);
            __builtin_amdgcn_fence(__ATOMIC_ACQUIRE, "agent");
            xb_add(&bar[XB_XGEN(b.x)], 1u);
            asm volatile("s_waitcnt vmcnt(0)" ::: "memory");
        } else {
            XB_SPIN(xb_ld(&bar[XB_XGEN(b.x)]) == gen, bar);
            __builtin_amdgcn_fence(__ATOMIC_ACQUIRE, "agent");
            asm volatile("s_waitcnt vmcnt(0)" ::: "memory");
        }
    }
    __syncthreads();
}

struct Frame {
    LAS unsigned char* lds;
    int tid, lane, wave, G, bid;
    const float* in[22]; float* out; unsigned char* ws;
};

struct TItem { const float* W; const float* gain; bf16* WT; int K, N, mode, item; };
__device__ __forceinline__ void t_issue(const TItem& t, int lane, f32x4 (&a)[8], f32x4 (&b)[8]) {
    const int nblk = (t.N + 127) / 128, kb = t.item / nblk, nb = t.item % nblk, k0 = 32 * kb, n0 = 128 * nb;
    const int n4 = lane & 31, kh = lane >> 5; const bool nok = (n0 + 4 * n4) < t.N;
#pragma unroll
    for (int j = 0; j < 8; ++j) {
        const float* p = t.W + (size_t)(k0 + 2 * (kh + 2 * j)) * t.N + n0 + 4 * n4;
        a[j] = nok ? __builtin_nontemporal_load((const f32x4*)p) : (f32x4){0.f, 0.f, 0.f, 0.f}; b[j] = nok ? __builtin_nontemporal_load((const f32x4*)(p + t.N)) : (f32x4){0.f, 0.f, 0.f, 0.f};
    }
}
__device__ __forceinline__ void t_finish(const TItem& t, LAS float* scr_, int lane, const f32x4 (&a)[8], const f32x4 (&b)[8]) {
    LAS unsigned* scr = (LAS unsigned*)scr_;
    const int nblk = (t.N + 127) / 128, kb = t.item / nblk, nb = t.item % nblk, k0 = 32 * kb, n0 = 128 * nb;
    const int n4 = lane & 31, kh = lane >> 5;
#pragma unroll
    for (int j = 0; j < 8; ++j) {
        const int kp = kh + 2 * j; const float ga = t.gain ? t.gain[k0 + 2 * kp] : 1.f, gb = t.gain ? t.gain[k0 + 2 * kp + 1] : 1.f;
        u32x4 w; w.x = pk2(a[j][0] * ga, b[j][0] * gb); w.y = pk2(a[j][1] * ga, b[j][1] * gb); w.z = pk2(a[j][2] * ga, b[j][2] * gb); w.w = pk2(a[j][3] * ga, b[j][3] * gb);
        *(LAS u32x4*)(scr + kp * 132 + 4 * n4) = w;
    }
    asm volatile("s_waitcnt lgkmcnt(0)" ::: "memory");
    const int kc = lane & 3;
#pragma unroll
    for (int r = 0; r < 8; ++r) {
        const int n = (lane >> 2) + 16 * r, nc = n0 + n; const LAS unsigned* s = scr + (4 * kc) * 132 + n;
        u32x4 o; o.x = s[0]; o.y = s[132]; o.z = s[264]; o.w = s[396];
        if (nc < t.N) { const int row = t.mode == 0 ? nc : (256 * (nc >> 7) + (nc & 127) + (t.mode == 2 ? 128 : 0)); *(u32x4*)(t.WT + (size_t)row * t.K + k0 + 8 * kc) = o; }
    }
    asm volatile("s_waitcnt lgkmcnt(0)" ::: "memory");
}
__device__ __forceinline__ void ffn_item(int r, const float* wg, const float* wu, const float* wd, const float* gain, bf16* Wgu, bf16* Wd, TItem& t) {
    constexpr int I_G = (DM / 32) * (DFF / 128);
    if (r < I_G) { t = TItem{wg, gain, Wgu, DM, DFF, 1, r}; }
    else if (r < 2 * I_G) { t = TItem{wu, gain, Wgu, DM, DFF, 2, r - I_G}; }
    else { t = TItem{wd, nullptr, Wd, DFF, DM, 0, r - 2 * I_G}; }
}
constexpr int FFN_ITEMS = 2 * (DM / 32) * (DFF / 128) + (DFF / 32) * (DM / 128);
__device__ __forceinline__ void convert_ffn(Frame& F, const float* wg, const float* wu, const float* wd, const float* gain, bf16* Wgu, bf16* Wd) {
    LAS float* scr = (LAS float*)(F.lds + F.wave * 16384);
    const int gw = F.bid * NWAVES + F.wave, NGW = F.G * NWAVES;
    f32x4 a0[8], b0[8], a1[8], b1[8]; TItem cur, nxt;
    int it = gw; bool hc = it < FFN_ITEMS;
    if (hc) { ffn_item(it, wg, wu, wd, gain, Wgu, Wd, cur); t_issue(cur, F.lane, a0, b0); }
    while (hc) {
        it += NGW; const bool hn = it < FFN_ITEMS;
        if (hn) { ffn_item(it, wg, wu, wd, gain, Wgu, Wd, nxt); t_issue(nxt, F.lane, a1, b1); }
        t_finish(cur, scr, F.lane, a0, b0);
        cur = nxt; hc = hn;
#pragma unroll
        for (int j = 0; j < 8; ++j) { a0[j] = a1[j]; b0[j] = b1[j]; }
    }
}
constexpr int Q1_D = (DFF / 32) * (DM / 128), Q1_IN = (DM / 32) * ((NIN + 127) / 128), Q1_OUT = (DM / 32) * (DM / 128), Q1_ITEMS = Q1_D + Q1_IN + Q1_OUT;
__device__ __forceinline__ void q1_item(Frame& F, int r, TItem& t) {
    if (r < Q1_D) t = TItem{F.in[I_F1D], nullptr, (bf16*)(F.ws + WS_WD1), DFF, DM, 0, r};
    else if (r < Q1_D + Q1_IN) t = TItem{F.in[I_WIN], F.in[I_MIXN], (bf16*)(F.ws + WS_WIN), DM, NIN, 0, r - Q1_D};
    else t = TItem{F.in[I_WOUT], nullptr, (bf16*)(F.ws + WS_WOUT), DM, DM, 0, r - Q1_D - Q1_IN};
}
template <int QID>
__device__ __forceinline__ void convert_queue(Frame& F, unsigned* ctr, const unsigned* stop) {
    LAS float* scr = (LAS float*)(F.lds + F.wave * 16384);
    constexpr int NIT = QID ? Q1_ITEMS : FFN_ITEMS;
    for (;;) {
        if (stop && (unsigned)__builtin_amdgcn_readfirstlane((int)__hip_atomic_load(stop, __ATOMIC_RELAXED, __HIP_MEMORY_SCOPE_AGENT)) >= 128u) break;
        unsigned base = 0; if (F.lane == 0) base = __hip_atomic_fetch_add(ctr, 4u, __ATOMIC_RELAXED, __HIP_MEMORY_SCOPE_AGENT);
        base = (unsigned)__builtin_amdgcn_readfirstlane((int)base);
        if (base >= (unsigned)NIT) break;
        const int end = ((int)base + 4 < NIT) ? (int)base + 4 : NIT;
        f32x4 a0[8], b0[8], a1[8], b1[8]; TItem cur, nxt;
#define Q_ITEM(r, t) do { if (QID) q1_item(F, (r), t); else ffn_item((r), F.in[I_F2G], F.in[I_F2U], F.in[I_F2D], F.in[I_F2N], (bf16*)(F.ws + WS_WGU2), (bf16*)(F.ws + WS_WD2), t); } while (0)
        int it = (int)base; Q_ITEM(it, cur); t_issue(cur, F.lane, a0, b0);
        for (;;) {
            ++it; const bool hn = it < end;
            if (hn) { Q_ITEM(it, nxt); t_issue(nxt, F.lane, a1, b1); }
            t_finish(cur, scr, F.lane, a0, b0);
            if (!hn) break;
            cur = nxt;
#pragma unroll
            for (int j = 0; j < 8; ++j) { a0[j] = a1[j]; b0[j] = b1[j]; }
        }
#undef Q_ITEM
    }
}

__device__ __forceinline__ void phase_p0(Frame& F) {
    {
        LAS float* scr = (LAS float*)(F.lds + F.wave * 16384);
        const int gw = F.bid * NWAVES + F.wave, NGW = F.G * NWAVES; constexpr int NI = 2 * (DM / 32) * (DFF / 128);
        f32x4 a0[8], b0[8], a1[8], b1[8]; TItem cur, nxt;
        int it = gw; bool hc = it < NI;
        if (hc) { ffn_item(it, F.in[I_F1G], F.in[I_F1U], F.in[I_F1D], F.in[I_F1N], (bf16*)(F.ws + WS_WGU1), (bf16*)(F.ws + WS_WD1), cur); t_issue(cur, F.lane, a0, b0); }
        while (hc) {
            it += NGW; const bool hn = it < NI;
            if (hn) { ffn_item(it, F.in[I_F1G], F.in[I_F1U], F.in[I_F1D], F.in[I_F1N], (bf16*)(F.ws + WS_WGU1), (bf16*)(F.ws + WS_WD1), nxt); t_issue(nxt, F.lane, a1, b1); }
            t_finish(cur, scr, F.lane, a0, b0);
            cur = nxt; hc = hn;
#pragma unroll
            for (int j = 0; j < 8; ++j) { a0[j] = a1[j]; b0[j] = b1[j]; }
        }
    }
    const int gw = F.bid * NWAVES + F.wave, NGW = F.G * NWAVES;
    { u32x4* z = (u32x4*)(F.ws + WS_WIN + (size_t)NIN * DM * 2); const int n16 = (NINP - NIN) * DM * 2 / 16;
      for (int i = F.bid * NTHR + F.tid; i < n16; i += F.G * NTHR) z[i] = (u32x4){0u, 0u, 0u, 0u}; }
    bf16* XB0 = (bf16*)(F.ws + WS_XB0); float* ssq0 = (float*)(F.ws + WS_SSQ0);
    f32x4 v[8], vn[8];
#define XROW(r_) ((const f32x4*)(((r_) < MP) ? F.in[I_XP] + (size_t)(r_) * DM : F.in[I_XS] + (size_t)((r_) - MP) * DM) + F.lane)
    if (gw < MT) { const f32x4* xr = XROW(gw);
#pragma unroll
        for (int j = 0; j < 8; ++j) v[j] = __builtin_nontemporal_load(xr + 64 * j); }
    for (int row = gw; row < MT; row += NGW) {
        const int rn = row + NGW;
        if (rn < MT) { const f32x4* xr = XROW(rn);
#pragma unroll
            for (int j = 0; j < 8; ++j) vn[j] = __builtin_nontemporal_load(xr + 64 * j); }
        float s = 0.f;
#pragma unroll
        for (int j = 0; j < 8; ++j) s += (v[j][0] * v[j][0] + v[j][1] * v[j][1]) + (v[j][2] * v[j][2] + v[j][3] * v[j][3]);
        s = wave_sum(s);
        u32x2* o = (u32x2*)(XB0 + (size_t)row * DM) + F.lane;
#pragma unroll
        for (int j = 0; j < 8; ++j) { u32x2 w; w.x = pk2(v[j][0], v[j][1]); w.y = pk2(v[j][2], v[j][3]); o[64 * j] = w; }
        if (F.lane < 32) ssq0[(size_t)row * 32 + F.lane] = (F.lane == 0) ? s : 0.f;
#pragma unroll
        for (int j = 0; j < 8; ++j) v[j] = vn[j];
    }
#undef XROW
}

__device__ __forceinline__ void resid_fixup(Frame& F, const SplitOrder& S, const float* resp, const float* ress, float* out, bf16* outb, float* ssq, float scale, const float* slab) {
    if (!S.split) return;
    const int nsp = S.nwg - S.G, gw = F.bid * NWAVES + F.wave, NGW = F.G * NWAVES, lane = F.lane;
    for (int task = gw; task < nsp * 256; task += NGW) {
        const int j = task >> 8, r = task & 255; Unit u; S.tile(S.G + j, u);
        const int row = u.pm * 256 + r, col = u.pn * 256 + 4 * lane;
        const float* sp = slab + (size_t)(j * 4) * 65536 + r * 256 + 4 * lane;
        const f32x4 p0 = *(const f32x4*)sp, p1 = *(const f32x4*)(sp + 65536), p2 = *(const f32x4*)(sp + 2 * 65536), p3 = *(const f32x4*)(sp + 3 * 65536);
        const float* rb = (row < MP) ? resp + (size_t)row * DM : ress + (size_t)(row - MP) * DM;
        const f32x4 v = *(const f32x4*)(rb + col) + ((p0 + p1) + (p2 + p3)) * scale;
        *(f32x4*)(out + (size_t)row * DM + col) = v;
        if (outb) { u32x2 w; w.x = pk2(v[0], v[1]); w.y = pk2(v[2], v[3]); *(u32x2*)(outb + (size_t)row * DM + col) = w; }
        float ss = (v[0] * v[0] + v[1] * v[1]) + (v[2] * v[2] + v[3] * v[3]);
        ss += __shfl_xor(ss, 1); ss += __shfl_xor(ss, 2); ss += __shfl_xor(ss, 4); ss += __shfl_xor(ss, 8);
        if ((lane & 15) == 0) ssq[(size_t)row * 32 + u.pn * 4 + (lane >> 4)] = ss;
    }
}
__device__ __forceinline__ float shx(float v, int lane, int o) { return __builtin_bit_cast(float, __builtin_amdgcn_ds_bpermute((lane ^ o) << 2, __builtin_bit_cast(int, v))); }
__device__ __forceinline__ float wave_sum_l(float v, int lane) {
#pragma unroll
    for (int o = 1; o < 64; o <<= 1) v += shx(v, lane, o);
    return v;
}
constexpr int ST = 132, ST2 = 68;
__device__ __forceinline__ bf16x8 rowfrag(const LAS float* buf, int row, int col) {
    const f32x4 lo = *(const LAS f32x4*)(buf + row * ST + col), hi = *(const LAS f32x4*)(buf + row * ST + col + 4);
    u32x4 w; w.x = pk2(lo[0], lo[1]); w.y = pk2(lo[2], lo[3]); w.z = pk2(hi[0], hi[1]); w.w = pk2(hi[2], hi[3]);
    return __builtin_bit_cast(bf16x8, w);
}
__device__ __forceinline__ void write_afrag(bf16* out, const LAS float* buf, int stride, int nks, const LAS float* rs, float sc, int tid) {
    const int total = 4 * nks * 64;
    for (int p = tid; p < total; p += NTHR) {
        const int lane = p & 63, f = p >> 6, ks = f % nks, mt = f / nks, fr = lane & 15, fq = lane >> 4, t = 16 * mt + fr;
        const LAS float* src = buf + t * stride + 32 * ks + 4 * fq;
        const f32x4 lo = *(const LAS f32x4*)src, hi = *(const LAS f32x4*)(src + 16);
        const float s = rs ? sc * rs[t] : sc;
        u32x4 w; w.x = pk2(lo[0] * s, lo[1] * s); w.y = pk2(lo[2] * s, lo[3] * s); w.z = pk2(hi[0] * s, hi[1] * s); w.w = pk2(hi[2] * s, hi[3] * s);
        *(u32x4*)(out + (size_t)p * 8) = w;
    }
}
__device__ __forceinline__ void write_tfrag(bf16* out, const LAS float* buf, const LAS float* rs, int tid) {
    for (int p = tid; p < 16 * 64; p += NTHR) {
        const int lane = p & 63, f = p >> 6, ksp = f & 1, dt = f >> 1, fr = lane & 15, fq = lane >> 4, col = 16 * dt + fr;
        float v[8];
#pragma unroll
        for (int j = 0; j < 8; ++j) { const int t = 32 * ksp + 16 * (j >> 2) + 4 * fq + (j & 3); v[j] = buf[t * ST + col] * (rs ? rs[t] : 1.f); }
        u32x4 w; w.x = pk2(v[0], v[1]); w.y = pk2(v[2], v[3]); w.z = pk2(v[4], v[5]); w.w = pk2(v[6], v[7]);
        *(u32x4*)(out + (size_t)p * 8) = w;
    }
}

#define LDS_BAR() do { asm volatile("s_waitcnt lgkmcnt(0)" ::: "memory"); __builtin_amdgcn_s_barrier(); asm volatile("" ::: "memory"); } while (0)
__device__ __forceinline__ void phase_a(Frame& F, const int aflags) {
    LAS float* qf = (LAS float*)F.lds; LAS float* kf = qf + 64 * ST; LAS float* vf = kf + 64 * ST;
    LAS float* amT = vf + 64 * ST; LAS float* qkb = amT + 64 * ST2; LAS float* gcs = qkb + 64 * ST2; LAS float* bet = gcs + 64; LAS float* eg = bet + 64; LAS float* ksc = eg + 64;
    const bf16* P = (const bf16*)(F.ws + WS_P); const float* GAGB = (const float*)(F.ws + WS_GAGB);
    const int wave = F.wave;
    unsigned short gpre[64]; unsigned ghr[3]; float gcw[4];
#define GDN_PREFETCH_A(itn_, tid_) do { _Pragma("unroll") for (int t = 0; t < 32; ++t) gpre[t] = 0; ghr[0] = ghr[1] = ghr[2] = 0u; gcw[0] = gcw[1] = gcw[2] = gcw[3] = 0.f;     \
        if ((itn_) < NITEM && (tid_) < 384) { const int h_ = (itn_) / NCH, c_ = (itn_) % NCH, ch_ = ((tid_) >> 7) * 1024 + h_ * 128 + ((tid_) & 127); \
        const float* cw_ = F.in[I_CONVW]; gcw[0] = cw_[ch_]; gcw[1] = cw_[3072 + ch_]; gcw[2] = cw_[2 * 3072 + ch_]; gcw[3] = cw_[3 * 3072 + ch_]; \
        if (c_ >= 128) { const unsigned* sc_ = (const unsigned*)(F.in[I_SCONV] + (size_t)(c_ - 128) * 3 * 3072 + ch_); ghr[0] = sc_[0]; ghr[1] = sc_[3072]; ghr[2] = sc_[2 * 3072]; } \
        else if (c_ > 0) { const bf16* pp_ = P + (size_t)(64 * c_ - 3) * PW + 3072 + ch_; ghr[0] = pp_[0]; ghr[1] = pp_[PW]; ghr[2] = pp_[2 * PW]; } \
        const bf16* pr_ = P + (size_t)(64 * c_) * PW + 3072 + ch_; \
        _Pragma("unroll") for (int t = 0; t < 32; ++t) gpre[t] = __builtin_nontemporal_load(pr_ + (size_t)t * PW); } } while (0)
#define GDN_PREFETCH_B(itn_, tid_) do { _Pragma("unroll") for (int t = 32; t < 64; ++t) gpre[t] = 0; \
        if ((itn_) < NITEM && (tid_) < 384) { const int h_ = (itn_) / NCH, c_ = (itn_) % NCH, ch_ = ((tid_) >> 7) * 1024 + h_ * 128 + ((tid_) & 127); \
        const bf16* pr_ = P + (size_t)(64 * c_) * PW + 3072 + ch_; \
        _Pragma("unroll") for (int t = 32; t < 64; ++t) gpre[t] = __builtin_nontemporal_load(pr_ + (size_t)t * PW); } } while (0)
    ghr[0] = ghr[1] = ghr[2] = 0u;
    if (!(aflags & 2)) { const int tid0 = wave * 64 + fresh_lane(); GDN_PREFETCH_A(F.bid, tid0); GDN_PREFETCH_B(F.bid, tid0); }
    if (!(aflags & 2))
    for (int it = F.bid; it < NITEM; it += F.G) {
        const int h = it / NCH, c = it % NCH, item = it;
        const int row0 = 64 * c;
        const int lane = fresh_lane(), tid = wave * 64 + lane, fr = lane & 15, fq = lane >> 4;
        {
            if (tid < 384) {
                const int X = tid >> 7, col = tid & 127;
                const float c0 = gcw[0], c1 = gcw[1], c2 = gcw[2], c3 = gcw[3];
                float x0, x1, x2;
                if (c >= 128) { x0 = __builtin_bit_cast(float, ghr[0]); x1 = __builtin_bit_cast(float, ghr[1]); x2 = __builtin_bit_cast(float, ghr[2]); }
                else if (c > 0) { x0 = bf2f((unsigned short)ghr[0]); x1 = bf2f((unsigned short)ghr[1]); x2 = bf2f((unsigned short)ghr[2]); }
                else { x0 = 0.f; x1 = 0.f; x2 = 0.f; }
                LAS float* dst = (X == 0 ? qf : (X == 1 ? kf : vf)) + col;
#pragma unroll
                for (int t = 0; t < 64; ++t) { const float x3 = bf2f(gpre[t]); float y = x0 * c0; y += x1 * c1; y += x2 * c2; y += x3 * c3; dst[t * ST] = silu_f(y); x0 = x1; x1 = x2; x2 = x3; }
            } else if (tid < 448) {
                const int t = tid - 384; const float ga = GAGB[(size_t)(row0 + t) * 16 + h], gb = GAGB[(size_t)(row0 + t) * 16 + 8 + h];
                const float xx = ga + F.in[I_DTB][h]; const float sp = fmaxf(xx, 0.f) + log1pf(expf(-fabsf(xx)));
                float g = -expf(F.in[I_ALOG][h]) * sp;
#pragma unroll
                for (int o = 1; o < 64; o <<= 1) { const float n = __builtin_bit_cast(float, __builtin_amdgcn_ds_bpermute(((lane - o) & 63) << 2, __builtin_bit_cast(int, g))); if (t >= o) g += n; }
                const float g63 = __builtin_bit_cast(float, __builtin_amdgcn_readlane(__builtin_bit_cast(int, g), 63));
                gcs[t] = g; bet[t] = 1.f / (1.f + expf(-gb)); eg[t] = expf(g); ksc[t] = expf(g63 - g);
                if (t == 63) ((float*)(F.ws + WS_CDG))[item] = expf(g);
            }
            LDS_BAR();
            for (int rr = wave; rr < 128; rr += NWAVES) {
                LAS float* b = (rr < 64 ? qf : kf) + (rr & 63) * ST; const float a0 = b[lane], a1 = b[lane + 64];
                const float ss = wave_sum_l(a0 * a0 + a1 * a1, lane); const float sc = rsqrtf(ss + EPS) * (rr < 64 ? 0.08838834764831845f : 1.f);
                b[lane] = a0 * sc; b[lane + 64] = a1 * sc;
            }
            LDS_BAR();
            {
                const int mat = wave >> 2, mt = wave & 3; const LAS float* asrc = mat ? qf : kf;
                bf16x8 a[4];
#pragma unroll
                for (int ks = 0; ks < 4; ++ks) a[ks] = rowfrag(asrc, 16 * mt + fr, 32 * ks + 8 * fq);
#pragma unroll
                for (int nt = 0; nt < 4; ++nt) {
                    f32x4 acc = {0.f, 0.f, 0.f, 0.f};
#pragma unroll
                    for (int ks = 0; ks < 4; ++ks) acc = __builtin_amdgcn_mfma_f32_16x16x32_bf16(a[ks], rowfrag(kf, 16 * nt + fr, 32 * ks + 8 * fq), acc, 0, 0, 0);
                    const int s = 16 * nt + fr;
#pragma unroll
                    for (int i = 0; i < 4; ++i) {
                        const int t = 16 * mt + 4 * fq + i; const float dec = (t >= s) ? expf(gcs[t] - gcs[s]) : 0.f;
                        if (mat == 0) amT[s * ST2 + t] = (t > s) ? acc[i] * dec * bet[t] : 0.f;
                        else qkb[t * ST2 + s] = acc[i] * dec;
                    }
                }
            }
            LDS_BAR();
            write_afrag((bf16*)(F.ws + WS_QDG + (size_t)item * FR16), qf, ST, 4, eg, 1.f, tid);
            write_afrag((bf16*)(F.ws + WS_QKG + (size_t)item * FR8), qkb, ST2, 2, nullptr, 1.f, tid);
            write_tfrag((bf16*)(F.ws + WS_KDG + (size_t)item * FR16), kf, ksc, tid);
            f32x2 xv[32];
            if (tid < 256) {
                if (tid < 128) {
#pragma unroll
                    for (int t = 0; t < 64; t += 2) xv[t >> 1] = (f32x2){kf[t * ST + tid] * bet[t] * eg[t], kf[(t + 1) * ST + tid] * bet[t + 1] * eg[t + 1]};
                } else {
#pragma unroll
                    for (int t = 0; t < 64; t += 2) xv[t >> 1] = (f32x2){vf[t * ST + tid - 128] * bet[t], vf[(t + 1) * ST + tid - 128] * bet[t + 1]};
                }
            }
            LDS_BAR();
            GDN_PREFETCH_A(it + F.G, tid);
            if (tid < 256 && !(aflags & 1)) {
                int vz; asm volatile("v_mov_b32 %0, 0" : "=v"(vz));
                const LAS float* amv = amT + vz;
                f32x4 cur[16], nxt[16];
#pragma unroll
                for (int g = 0; g < 16; ++g) cur[g] = *(const LAS f32x4*)(amv + 4 * g);
#pragma unroll
                for (int s = 0; s < 63; ++s) {
                    if (s + 1 < 63) {
#pragma unroll
                        for (int g = (s + 2) >> 2; g < 16; ++g) nxt[g] = *(const LAS f32x4*)(amv + (s + 1) * ST2 + 4 * g);
                    }
                    const float xs = (s & 1) ? xv[s >> 1].y : xv[s >> 1].x; const f32x2 xs2 = {xs, xs};
#pragma unroll
                    for (int g = (s + 1) >> 2; g < 16; ++g) { xv[2 * g] -= (f32x2){cur[g][0], cur[g][1]} * xs2; xv[2 * g + 1] -= (f32x2){cur[g][2], cur[g][3]} * xs2; }
#pragma unroll
                    for (int g = 0; g < 16; ++g) cur[g] = nxt[g];
                    __builtin_amdgcn_sched_barrier(0);
                }
                LAS float* dst = (tid < 128) ? qf + tid : kf + (tid - 128);
#pragma unroll
                for (int t = 0; t < 64; t += 2) { dst[t * ST] = xv[t >> 1].x; dst[(t + 1) * ST] = xv[t >> 1].y; }
            }
            LDS_BAR();
            GDN_PREFETCH_B(it + F.G, tid);
            write_afrag((bf16*)(F.ws + WS_NW + (size_t)item * FR16), qf, ST, 4, nullptr, -1.f, tid);
            {
                bf16* U = (bf16*)(F.ws + WS_UG + (size_t)item * FR16);
                for (int p = tid; p < 32 * 64; p += NTHR) {
                    const int ln = p & 63, f = p >> 6, mt = f & 3, sl = f >> 2, r = ln & 15, q = ln >> 4;
                    const LAS float* s = kf + (16 * mt + 4 * q) * ST + 16 * sl + r;
                    u32x2 w; w.x = pk2(s[0], s[ST]); w.y = pk2(s[2 * ST], s[3 * ST]); *(u32x2*)(U + (size_t)p * 4) = w;
                }
            }
            LDS_BAR();
        }
    }
    unsigned short pre[64];
    const int it0r = (F.bid + F.G / 2) % F.G;
    if (!(aflags & 4) && it0r < NITEM) {
        const int tid0 = wave * 64 + fresh_lane();
        if (tid0 < 384) { const bf16* pr = P + (size_t)(64 * (it0r % NCH)) * PW + (tid0 >> 7) * 1024 + (it0r / NCH) * 128 + (tid0 & 127);
#pragma unroll
            for (int t = 0; t < 64; ++t) pre[t] = __builtin_nontemporal_load(pr + (size_t)t * PW); }
    }
    if (!(aflags & 4))
    for (int it = it0r; it < NITEM; it += F.G) {
        const int h = it / NCH, c = it % NCH, item = it;
        const int row0 = 64 * c;
        const int lane = fresh_lane(), tid = wave * 64 + lane, fr = lane & 15, fq = lane >> 4;
        {
            const float lg = logf(1.f - exp2f(-5.f - (float)h));
            if (tid < 384) {
                const int X = tid >> 7, col = tid & 127;
                LAS float* dst = (X == 0 ? qf : (X == 1 ? kf : vf)) + col;
#pragma unroll
                for (int t = 0; t < 64; ++t) dst[t * ST] = bf2f(pre[t]);
                const int itn = it + F.G;
                if (itn < NITEM) { const bf16* pr = P + (size_t)(64 * (itn % NCH)) * PW + X * 1024 + (itn / NCH) * 128 + col;
#pragma unroll
                    for (int t = 0; t < 64; ++t) pre[t] = __builtin_nontemporal_load(pr + (size_t)t * PW); }
            } else if (tid < 448) { const int t = tid - 384; eg[t] = expf((float)(t + 1) * lg); ksc[t] = expf((float)(63 - t) * lg); }
            LDS_BAR();
            {
                const float pos0 = (c < 128) ? (float)(64 * c) : 4096.f;
                const double invd = exp(-(double)(tid & 63) * (9.210340371976184 / 64.0)) * 0.15915494309189535;
#pragma unroll 2
                for (int r = 0; r < 8; ++r) {
                    const int idx = tid + NTHR * r, t = idx >> 6, i = idx & 63;
                    double rev = (double)(pos0 + (float)t) * invd; rev -= rint(rev);
                    const float rf = (float)rev; const float sn = __builtin_amdgcn_sinf(rf), cs = __builtin_amdgcn_cosf(rf);
                    const float q1 = qf[t * ST + i], q2 = qf[t * ST + i + 64], k1 = kf[t * ST + i], k2 = kf[t * ST + i + 64];
                    qf[t * ST + i] = (q1 * cs - q2 * sn) * 0.08838834764831845f; qf[t * ST + i + 64] = (q1 * sn + q2 * cs) * 0.08838834764831845f;
                    kf[t * ST + i] = k1 * cs - k2 * sn; kf[t * ST + i + 64] = k1 * sn + k2 * cs;
                }
            }
            LDS_BAR();
            if (wave < 4) {
                const int mt = wave; bf16x8 a[4];
#pragma unroll
                for (int ks = 0; ks < 4; ++ks) a[ks] = rowfrag(qf, 16 * mt + fr, 32 * ks + 8 * fq);
#pragma unroll
                for (int nt = 0; nt < 4; ++nt) {
                    f32x4 acc = {0.f, 0.f, 0.f, 0.f};
#pragma unroll
                    for (int ks = 0; ks < 4; ++ks) acc = __builtin_amdgcn_mfma_f32_16x16x32_bf16(a[ks], rowfrag(kf, 16 * nt + fr, 32 * ks + 8 * fq), acc, 0, 0, 0);
                    const int s = 16 * nt + fr;
#pragma unroll
                    for (int i = 0; i < 4; ++i) { const int t = 16 * mt + 4 * fq + i; qkb[t * ST2 + s] = (t >= s) ? acc[i] * expf((float)(t - s) * lg) : 0.f; }
                }
            }
            LDS_BAR();
            write_afrag((bf16*)(F.ws + WS_QDR + (size_t)item * FR16), qf, ST, 4, eg, 1.f, tid);
            write_afrag((bf16*)(F.ws + WS_SCR + (size_t)item * FR8), qkb, ST2, 2, nullptr, 1.f, tid);
            write_tfrag((bf16*)(F.ws + WS_KDR + (size_t)item * FR16), kf, ksc, tid);
            write_tfrag((bf16*)(F.ws + WS_VR + (size_t)item * FR16), vf, nullptr, tid);
            LDS_BAR();
        }
    }
}

__device__ __forceinline__ bf16x8 pack_acc2(const f32x4& a, const f32x4& b) {
    u32x4 w; w.x = pk2(a[0], a[1]); w.y = pk2(a[2], a[3]); w.z = pk2(b[0], b[1]); w.w = pk2(b[2], b[3]);
    return __builtin_bit_cast(bf16x8, w);
}
__device__ __forceinline__ void run_chain(Frame& F, int type, int item0, int nsteps, int ncw, int slice0, const float* S0, float* Sout) {
    const int tid = F.tid, lane = F.lane, wave = F.wave, fr = lane & 15, fq = lane >> 4;
    const bool comp = wave < ncw; const int sl = slice0 + wave;
    const unsigned char* srcW = F.ws + WS_NW + (size_t)tid * 16; const unsigned char* srcKD = F.ws + (type ? WS_KDG : WS_KDR) + (size_t)tid * 16;
    const unsigned char* UV = F.ws + (type ? WS_UG : WS_VR) + (size_t)sl * 2048 + (size_t)lane * (type ? 8 : 16);
    const float* CD = (const float*)(F.ws + WS_CDG);
    unsigned char* SP = F.ws + WS_SP + (size_t)type * NITEM * 32768 + (size_t)(sl * 4 * 64 + lane) * 16; unsigned char* DL = F.ws + WS_DL + (size_t)(sl * 2 * 64 + lane) * 16;
    const int head = item0 / NCH; const float cd_ret = expf(64.f * logf(1.f - exp2f(-5.f - (float)head)));
    u32x4 ra0, ra1, ra2, ra3, rb0, rb1, rb2, rb3, ua0, ua1, ub0, ub1;
    ra0 = ra1 = ra2 = ra3 = rb0 = rb1 = rb2 = rb3 = ua0 = ua1 = ub0 = ub1 = (u32x4){0u, 0u, 0u, 0u};
#define CH_GLOAD(q0, q1, q2, q3, item) do { const unsigned char* kd_ = srcKD + (size_t)(item) * FR16; q2 = *(const u32x4*)kd_; q3 = *(const u32x4*)(kd_ + 8192); \
        if (type) { const unsigned char* w_ = srcW + (size_t)(item) * FR16; q0 = *(const u32x4*)w_; q1 = *(const u32x4*)(w_ + 8192); } } while (0)
#define CH_LSTORE(q0, q1, q2, q3, buf) do { LAS unsigned char* d_ = F.lds + (buf) * 32768 + tid * 16; *(LAS u32x4*)(d_ + 16384) = q2; *(LAS u32x4*)(d_ + 16384 + 8192) = q3; \
        if (type) { *(LAS u32x4*)d_ = q0; *(LAS u32x4*)(d_ + 8192) = q1; } } while (0)
#define CH_LOADUV(d0, d1, item) do { const unsigned char* p_ = UV + (size_t)(item) * FR16; \
        if (type) { const u32x2 a_ = *(const u32x2*)p_, b_ = *(const u32x2*)(p_ + 512), c_ = *(const u32x2*)(p_ + 1024), e_ = *(const u32x2*)(p_ + 1536); d0 = (u32x4){a_.x, a_.y, b_.x, b_.y}; d1 = (u32x4){c_.x, c_.y, e_.x, e_.y}; } \
        else { d0 = *(const u32x4*)p_; d1 = *(const u32x4*)(p_ + 1024); } } while (0)
#define CH_BAR() do { asm volatile("s_waitcnt lgkmcnt(0)" ::: "memory"); __builtin_amdgcn_s_barrier(); asm volatile("" ::: "memory"); } while (0)
    CH_GLOAD(ra0, ra1, ra2, ra3, item0); CH_LSTORE(ra0, ra1, ra2, ra3, 0);
    if (nsteps > 1) CH_GLOAD(rb0, rb1, rb2, rb3, item0 + 1);
    f32x4 S[8];
#pragma unroll
    for (int dt = 0; dt < 8; ++dt) {
        S[dt] = (f32x4){0.f, 0.f, 0.f, 0.f};
        if (S0 && comp) {
#pragma unroll
            for (int i = 0; i < 4; ++i) S[dt][i] = S0[(size_t)(16 * dt + 4 * fq + i) * 128 + 16 * sl + fr];
        }
    }
    if (comp) { CH_LOADUV(ua0, ua1, item0); if (nsteps > 1) CH_LOADUV(ub0, ub1, item0 + 1); }
    float cdn = type ? CD[item0] : cd_ret;
    CH_BAR();
#define CH_STEP(p0, p1, p2, p3, up0, up1, q0, q1, q2, q3, ST_) do { \
        const int st_ = (ST_), item = item0 + st_; \
        if (st_ + 2 < nsteps) CH_GLOAD(p0, p1, p2, p3, item + 2); \
        const float cd = cdn; if (type && st_ + 1 < nsteps) cdn = CD[item + 1]; \
        if (comp) { \
            const LAS unsigned char* lb = F.lds + (st_ & 1) * 32768 + lane * 16; \
            bf16x8 Sb[4]; \
            _Pragma("unroll") for (int ks = 0; ks < 4; ++ks) { Sb[ks] = pack_acc2(S[2 * ks], S[2 * ks + 1]); *(bf16x8*)(SP + (size_t)item * 32768 + (size_t)ks * 1024) = Sb[ks]; } \
            bf16x8 db0, db1; \
            if (type) { \
                f32x4 dl[4]; \
                dl[0] = (f32x4){bf2f(up0.x & 0xffff), bf2f(up0.x >> 16), bf2f(up0.y & 0xffff), bf2f(up0.y >> 16)}; \
                dl[1] = (f32x4){bf2f(up0.z & 0xffff), bf2f(up0.z >> 16), bf2f(up0.w & 0xffff), bf2f(up0.w >> 16)}; \
                dl[2] = (f32x4){bf2f(up1.x & 0xffff), bf2f(up1.x >> 16), bf2f(up1.y & 0xffff), bf2f(up1.y >> 16)}; \
                dl[3] = (f32x4){bf2f(up1.z & 0xffff), bf2f(up1.z >> 16), bf2f(up1.w & 0xffff), bf2f(up1.w >> 16)}; \
                _Pragma("unroll") for (int ks = 0; ks < 4; ++ks) \
                    _Pragma("unroll") for (int mt = 0; mt < 4; ++mt) dl[mt] = __builtin_amdgcn_mfma_f32_16x16x32_bf16(*(const LAS bf16x8*)(lb + (mt * 4 + ks) * 1024), Sb[ks], dl[mt], 0, 0, 0); \
                db0 = pack_acc2(dl[0], dl[1]); db1 = pack_acc2(dl[2], dl[3]); \
                *(bf16x8*)(DL + (size_t)item * FR16) = db0; *(bf16x8*)(DL + (size_t)item * FR16 + 1024) = db1; \
            } else { db0 = __builtin_bit_cast(bf16x8, up0); db1 = __builtin_bit_cast(bf16x8, up1); } \
            if (st_ + 2 < nsteps) CH_LOADUV(up0, up1, item + 2); \
            _Pragma("unroll") for (int dt = 0; dt < 8; ++dt) S[dt] = S[dt] * cd; \
            _Pragma("unroll") for (int dt = 0; dt < 8; ++dt) S[dt] = __builtin_amdgcn_mfma_f32_16x16x32_bf16(*(const LAS bf16x8*)(lb + 16384 + (dt * 2 + 0) * 1024), db0, S[dt], 0, 0, 0); \
            _Pragma("unroll") for (int dt = 0; dt < 8; ++dt) S[dt] = __builtin_amdgcn_mfma_f32_16x16x32_bf16(*(const LAS bf16x8*)(lb + 16384 + (dt * 2 + 1) * 1024), db1, S[dt], 0, 0, 0); \
        } \
        if (st_ + 1 < nsteps) CH_LSTORE(q0, q1, q2, q3, (st_ + 1) & 1); \
        CH_BAR(); \
    } while (0)
    for (int st = 0; st < nsteps; st += 2) {
        CH_STEP(ra0, ra1, ra2, ra3, ua0, ua1, rb0, rb1, rb2, rb3, st);
        if (st + 1 < nsteps) CH_STEP(rb0, rb1, rb2, rb3, ub0, ub1, ra0, ra1, ra2, ra3, st + 1);
    }
#undef CH_STEP
#undef CH_BAR
#undef CH_GLOAD
#undef CH_LSTORE
#undef CH_LOADUV
    if (comp) {
#pragma unroll
        for (int dt = 0; dt < 8; ++dt)
#pragma unroll
            for (int i = 0; i < 4; ++i) Sout[(size_t)(16 * dt + 4 * fq + i) * 128 + 16 * sl + fr] = S[dt][i];
    }
    __syncthreads();
}
constexpr int RB = 34816;
#define DMA16(gp, ldsoff) __builtin_amdgcn_global_load_lds((const unsigned*)(gp), (LAS unsigned*)(F.lds + (ldsoff)), 16, 0, 0)
template <int NLD>
__device__ __forceinline__ void chain_loader(Frame& F, const unsigned char* g0, const unsigned char* g1, int l0, int l1, int lane) {
    constexpr int N0 = NLD < 4 ? NLD : 4;
    u32x4 R0[NLD], R1[NLD], R2[NLD], R3[NLD], R4[NLD];
#define L_LD(R, k) do { const size_t go_ = (size_t)(k) * FR16; _Pragma("unroll") for (int i = 0; i < N0; ++i) R[i] = *(const u32x4*)(g0 + go_ + i * 1024); \
        if (NLD == 8) { _Pragma("unroll") for (int i = 0; i < 4; ++i) R[(NLD == 8 ? 4 : 0) + i] = *(const u32x4*)(g1 + go_ + i * 1024); } } while (0)
#define L_ST(R, k) do { LAS unsigned char* d_ = F.lds + ((k) & 3) * RB + lane * 16; _Pragma("unroll") for (int i = 0; i < N0; ++i) *(LAS u32x4*)(d_ + l0 + i * 1024) = R[i]; \
        if (NLD == 8) { _Pragma("unroll") for (int i = 0; i < 4; ++i) *(LAS u32x4*)(d_ + l1 + i * 1024) = R[(NLD == 8 ? 4 : 0) + i]; } } while (0)
#define L_BAR() do { asm volatile("s_waitcnt lgkmcnt(0)" ::: "memory"); __builtin_amdgcn_s_barrier(); asm volatile("" ::: "memory"); } while (0)
    L_LD(R0, 0); L_LD(R1, 1); L_LD(R2, 2); L_LD(R3, 3); L_LD(R4, 4);
    L_ST(R0, 0); L_LD(R0, 5); L_ST(R1, 1); L_LD(R1, 6); L_BAR();
    for (int s = 0; s < 120; s += 10) {
        L_ST(R2, s + 2); L_LD(R2, s + 7); L_ST(R3, s + 3); L_LD(R3, s + 8); L_BAR();
        L_ST(R4, s + 4); L_LD(R4, s + 9); L_ST(R0, s + 5); L_LD(R0, s + 10); L_BAR();
        L_ST(R1, s + 6); L_LD(R1, s + 11); L_ST(R2, s + 7); L_LD(R2, s + 12); L_BAR();
        L_ST(R3, s + 8); L_LD(R3, s + 13); L_ST(R4, s + 9); L_LD(R4, s + 14); L_BAR();
        L_ST(R0, s + 10); L_LD(R0, s + 15); L_ST(R1, s + 11); L_LD(R1, s + 16); L_BAR();
    }
    L_ST(R2, 122); L_LD(R2, 127); L_ST(R3, 123); L_BAR();
    L_ST(R4, 124); L_ST(R0, 125); L_BAR();
    L_ST(R1, 126); L_ST(R2, 127); L_BAR();
    L_BAR();
#undef L_LD
#undef L_ST
#undef L_BAR
}
__device__ __forceinline__ void run_chain_long(Frame& F, int type, int item0, int nsteps, int sl, float* Sout, const int bflags) {
    const int lane = F.lane, wave = F.wave, fr = lane & 15, fq = lane >> 4;
    if (wave == 0) {
        const float* CD = (const float*)(F.ws + WS_CDG);
        unsigned char* SP = F.ws + WS_SP + (size_t)type * NITEM * 32768 + (size_t)(sl * 4 * 64 + lane) * 16; unsigned char* DL = F.ws + WS_DL + (size_t)(sl * 2 * 64 + lane) * 16;
        const int head = item0 / NCH; const float cd_ret = expf(64.f * logf(1.f - exp2f(-5.f - (float)head)));
        f32x4 S[8];
#pragma unroll
        for (int dt = 0; dt < 8; ++dt) S[dt] = (f32x4){0.f, 0.f, 0.f, 0.f};
        LAS float* cdl = (LAS float*)(F.lds + 4 * RB);
        for (int i = lane; i < nsteps; i += 64) cdl[i] = type ? CD[item0 + i] : cd_ret;
        asm volatile("s_waitcnt vmcnt(0) lgkmcnt(0)" ::: "memory"); __builtin_amdgcn_s_barrier(); asm volatile("" ::: "memory");
        for (int st = 0; st < nsteps; ++st) {
            const int item = item0 + st; const float cd = cdl[st];
            const LAS unsigned char* lb = F.lds + (st & 3) * RB + lane * 16;
            bf16x8 Sb[4];
#pragma unroll
            for (int ks = 0; ks < 4; ++ks) { Sb[ks] = pack_acc2(S[2 * ks], S[2 * ks + 1]); *(bf16x8*)(SP + (size_t)item * 32768 + (size_t)ks * 1024) = Sb[ks]; }
            bf16x8 db0, db1;
            if (type) {
                const LAS unsigned char* ub = F.lds + (st & 3) * RB + 32768 + lane * 8;
                f32x4 dl[4];
#pragma unroll
                for (int mt = 0; mt < 4; ++mt) { const u32x2 u = *(const LAS u32x2*)(ub + mt * 512); dl[mt] = (f32x4){bf2f(u.x & 0xffff), bf2f(u.x >> 16), bf2f(u.y & 0xffff), bf2f(u.y >> 16)}; }
#pragma unroll
                for (int ks = 0; ks < 4; ++ks)
#pragma unroll
                    for (int mt = 0; mt < 4; ++mt) dl[mt] = __builtin_amdgcn_mfma_f32_16x16x32_bf16(*(const LAS bf16x8*)(lb + (mt * 4 + ks) * 1024), Sb[ks], dl[mt], 0, 0, 0);
                db0 = pack_acc2(dl[0], dl[1]); db1 = pack_acc2(dl[2], dl[3]);
                *(bf16x8*)(DL + (size_t)item * FR16) = db0; *(bf16x8*)(DL + (size_t)item * FR16 + 1024) = db1;
            } else { db0 = *(const LAS bf16x8*)(lb + 32768); db1 = *(const LAS bf16x8*)(lb + 32768 + 1024); }
#pragma unroll
            for (int dt = 0; dt < 8; ++dt) S[dt] = S[dt] * cd;
#pragma unroll
            for (int dt = 0; dt < 8; ++dt) S[dt] = __builtin_amdgcn_mfma_f32_16x16x32_bf16(*(const LAS bf16x8*)(lb + 16384 + (dt * 2 + 0) * 1024), db0, S[dt], 0, 0, 0);
#pragma unroll
            for (int dt = 0; dt < 8; ++dt) S[dt] = __builtin_amdgcn_mfma_f32_16x16x32_bf16(*(const LAS bf16x8*)(lb + 16384 + (dt * 2 + 1) * 1024), db1, S[dt], 0, 0, 0);
            if (st & 1) { asm volatile("s_waitcnt lgkmcnt(0)" ::: "memory"); __builtin_amdgcn_s_barrier(); asm volatile("" ::: "memory"); }
        }
#pragma unroll
        for (int dt = 0; dt < 8; ++dt)
#pragma unroll
            for (int i = 0; i < 4; ++i) Sout[(size_t)(16 * dt + 4 * fq + i) * 128 + 16 * sl + fr] = S[dt][i];
    } else {
        const unsigned char* srcW = F.ws + WS_NW + (size_t)item0 * FR16 + (size_t)lane * 16;
        const unsigned char* srcKD = F.ws + (type ? WS_KDG : WS_KDR) + (size_t)item0 * FR16 + (size_t)lane * 16;
        const unsigned char* srcUV = F.ws + (type ? WS_UG : WS_VR) + (size_t)item0 * FR16 + (size_t)sl * 2048 + (size_t)lane * 16;
        const int w4 = (wave - 1) * 4;
        if (wave <= 4) {
            if (type) chain_loader<8>(F, srcW + w4 * 1024, srcKD + w4 * 1024, w4 * 1024, 16384 + w4 * 1024, lane);
            else chain_loader<4>(F, srcKD + w4 * 1024, nullptr, 16384 + w4 * 1024, 0, lane);
        } else if (wave == 5) chain_loader<2>(F, srcUV, nullptr, 32768, 0, lane);
        else { for (int st = 0; st < 65; ++st) { __builtin_amdgcn_s_barrier(); asm volatile("" ::: "memory"); } }
    }
    __syncthreads();
}
__device__ __forceinline__ void phase_b(Frame& F, const int bflags) {
    const int b = F.bid;
    if (b < 128) {
        const int head = b & 7, slice = (b >> 3) & 7, type = b >> 6;
        run_chain_long(F, type, head * NCH, 128, slice, F.out + (type ? O_GDNP : O_RETP) + (size_t)head * 16384, bflags);
        if (F.tid == 0) __hip_atomic_fetch_add((unsigned*)(F.ws + WS_QCTR + 128), 1u, __ATOMIC_RELAXED, __HIP_MEMORY_SCOPE_AGENT);
    } else {
        for (int idx = b - 128; idx < 256; idx += F.G - 128) {
            const int type = idx >> 7, bb = (idx >> 3) & 15, head = idx & 7;
            run_chain(F, type, head * NCH + 128 + bb, 1, 8, 0, F.in[type ? I_SGDN : I_SRET] + (size_t)(bb * 8 + head) * 16384,
                      F.out + (type ? O_GDNS : O_RETS) + (size_t)(bb * 8 + head) * 16384);
        }
    }
    convert_queue<0>(F, (unsigned*)(F.ws + WS_QCTR), (const unsigned*)(F.ws + WS_QCTR + 128));
}

__device__ __forceinline__ void phase_c(Frame& F, const int cflags) {
    const int wave = F.wave, mt = wave & 3, grp = wave >> 2;
    const bf16* GATES = (const bf16*)(F.ws + WS_GATES); bf16* O = (bf16*)(F.ws + WS_O);
    LAS unsigned char* gb = F.lds + grp * 49152;
    LAS unsigned char* ew = F.lds + 98304 + wave * 4352;
    u32x4 fb[12]; bf16x8 aq[4], ak[2]; u32x4 gin[4]; float nwv[8];
#define C_LOAD(it_, lane_) do { const int type_ = (it_) / NITEM, rem_ = (it_) % NITEM, h_ = rem_ / NCH, c_ = rem_ % NCH; \
        const unsigned char* QD_ = F.ws + (type_ ? WS_QDG : WS_QDR) + (size_t)rem_ * FR16; const unsigned char* QK_ = F.ws + (type_ ? WS_QKG : WS_SCR) + (size_t)rem_ * FR8; \
        const unsigned char* SP_ = F.ws + WS_SP + ((size_t)type_ * NITEM + rem_) * 32768; const unsigned char* DV_ = F.ws + (type_ ? WS_DL : WS_VR) + (size_t)rem_ * FR16; \
        const size_t rb_ = (size_t)(64 * c_ + 16 * mt) * 2048 + type_ * 1024 + h_ * 128; \
        _Pragma("unroll") for (int j = 0; j < 12; ++j) { const int f = mt * 12 + j; fb[j] = __builtin_nontemporal_load((const u32x4*)((f < 32 ? SP_ + (size_t)f * 1024 : DV_ + (size_t)(f - 32) * 1024) + (size_t)(lane_) * 16)); } \
        _Pragma("unroll") for (int ks = 0; ks < 4; ++ks) aq[ks] = __builtin_nontemporal_load((const bf16x8*)(QD_ + (size_t)((mt * 4 + ks) * 64 + (lane_)) * 16)); \
        _Pragma("unroll") for (int k2 = 0; k2 < 2; ++k2) ak[k2] = __builtin_nontemporal_load((const bf16x8*)(QK_ + (size_t)((mt * 2 + k2) * 64 + (lane_)) * 16)); \
        _Pragma("unroll") for (int q = 0; q < 4; ++q) gin[q] = __builtin_nontemporal_load((const u32x4*)(GATES + rb_ + (size_t)((lane_) >> 2) * 2048 + ((lane_) & 3) * 32 + q * 8)); \
        const float* nw_ = type_ ? F.in[I_GDNN] : F.in[I_RETN] + h_ * 128; \
        _Pragma("unroll") for (int sl = 0; sl < 8; ++sl) nwv[sl] = nw_[16 * sl + ((lane_) & 15)]; } while (0)
    const int it0 = F.bid * 2 + grp;
    if (it0 < 2 * NITEM) { const int l0 = fresh_lane(); C_LOAD(it0, l0); }
    for (int it = it0; it < 2 * NITEM; it += 2 * F.G) {
        const int lane = fresh_lane(), fr = lane & 15, fq = lane >> 4;
        const int type = it / NITEM, rem = it % NITEM, h = rem / NCH, c = rem % NCH;
        const size_t rowbase = (size_t)(64 * c + 16 * mt) * 2048 + type * 1024 + h * 128;
        const int erow = lane >> 2, echk = lane & 3;
#pragma unroll
        for (int j = 0; j < 12; ++j) *(LAS u32x4*)(gb + (mt * 12 + j) * 1024 + lane * 16) = fb[j];
#pragma unroll
        for (int q = 0; q < 4; ++q) *(LAS u32x4*)(ew + erow * 272 + echk * 64 + q * 16) = gin[q];
        bf16x8 caq[4], cak[2]; float cnw[8];
#pragma unroll
        for (int ks = 0; ks < 4; ++ks) caq[ks] = aq[ks];
        cak[0] = ak[0]; cak[1] = ak[1];
#pragma unroll
        for (int sl = 0; sl < 8; ++sl) cnw[sl] = nwv[sl];
        if (it + 2 * F.G < 2 * NITEM) C_LOAD(it + 2 * F.G, lane);
        asm volatile("s_waitcnt lgkmcnt(0)" ::: "memory"); __builtin_amdgcn_s_barrier(); asm volatile("" ::: "memory");
        f32x4 o[8];
#pragma unroll
        for (int sl = 0; sl < 8; ++sl) {
            f32x4 acc = {0.f, 0.f, 0.f, 0.f};
#pragma unroll
            for (int ks = 0; ks < 4; ++ks) acc = __builtin_amdgcn_mfma_f32_16x16x32_bf16(caq[ks], *(const LAS bf16x8*)(gb + (sl * 4 + ks) * 1024 + lane * 16), acc, 0, 0, 0);
#pragma unroll
            for (int k2 = 0; k2 < 2; ++k2) acc = __builtin_amdgcn_mfma_f32_16x16x32_bf16(cak[k2], *(const LAS bf16x8*)(gb + (32 + sl * 2 + k2) * 1024 + lane * 16), acc, 0, 0, 0);
            o[sl] = acc;
        }
#pragma unroll
        for (int i = 0; i < 4; ++i) {
            float ss = 0.f;
#pragma unroll
            for (int sl = 0; sl < 8; ++sl) ss += o[sl][i] * o[sl][i];
            ss += __shfl_xor(ss, 1); ss += __shfl_xor(ss, 2); ss += __shfl_xor(ss, 4); ss += __shfl_xor(ss, 8);
            const float rn = rsqrtf(ss * (1.f / 128.f) + EPS);
            LAS unsigned short* er = (LAS unsigned short*)(ew + (4 * fq + i) * 272) + fr;
#pragma unroll
            for (int sl = 0; sl < 8; ++sl) { const float g = bf2f(er[16 * sl]); er[16 * sl] = (unsigned short)f2bf(o[sl][i] * rn * cnw[sl] * g); }
        }
        asm volatile("s_waitcnt lgkmcnt(0)" ::: "memory");
#pragma unroll
        for (int q = 0; q < 4; ++q) *(u32x4*)(O + rowbase + (size_t)erow * 2048 + echk * 32 + q * 8) = *(const LAS u32x4*)(ew + erow * 272 + echk * 64 + q * 16);
        asm volatile("s_waitcnt lgkmcnt(0)" ::: "memory"); __builtin_amdgcn_s_barrier(); asm volatile("" ::: "memory");
    }
#undef C_LOAD
}

__device__ __forceinline__ void phase_final(Frame& F, const SplitOrder& S) {
    const int gw = F.bid * NWAVES + F.wave, NGW = F.G * NWAVES; const float* g = F.in[I_FINN]; const float* slab = (const float*)(F.ws + WS_SLAB);
    LAS unsigned char* tab = F.lds;
    for (int i = F.tid; i < (MT / 256) * 8; i += NTHR) tab[i] = 0;
    __syncthreads();
    if (S.split && F.tid < S.nwg - S.G) { Unit u; S.tile((long)S.G + F.tid, u); tab[u.pm * 8 + u.pn] = (unsigned char)(F.tid + 1); }
    __syncthreads();
    const f32x4* gr = (const f32x4*)g + F.lane; f32x4 gg[8];
#pragma unroll
    for (int j = 0; j < 8; ++j) gg[j] = gr[64 * j];
    f32x4 v[8], vn[8];
    if (gw < MT) { const f32x4* xr = (const f32x4*)(F.out + (size_t)gw * DM) + F.lane;
#pragma unroll
        for (int j = 0; j < 8; ++j) v[j] = xr[64 * j]; }
    for (int row = gw; row < MT; row += NGW) {
        const int rn = row + NGW;
        if (rn < MT) { const f32x4* xr = (const f32x4*)(F.out + (size_t)rn * DM) + F.lane;
#pragma unroll
            for (int j = 0; j < 8; ++j) vn[j] = xr[64 * j]; }
        const int pm = row >> 8, r = row & 255;
#pragma unroll
        for (int j = 0; j < 8; ++j) {
            const int t = tab[pm * 8 + j];
            if (t) { const float* sp = slab + (size_t)((t - 1) * 4) * 65536 + r * 256 + 4 * F.lane;
                const f32x4 p0 = *(const f32x4*)sp, p1 = *(const f32x4*)(sp + 65536), p2 = *(const f32x4*)(sp + 2 * 65536), p3 = *(const f32x4*)(sp + 3 * 65536);
                v[j] += ((p0 + p1) + (p2 + p3)) * 0.5f; }
        }
        float ss = 0.f;
#pragma unroll
        for (int j = 0; j < 8; ++j) ss += (v[j][0] * v[j][0] + v[j][1] * v[j][1]) + (v[j][2] * v[j][2] + v[j][3] * v[j][3]);
        ss = wave_sum(ss); const float rr = rsqrtf(ss * (1.f / DM) + EPS);
        f32x4* xo = (f32x4*)(F.out + (size_t)row * DM) + F.lane;
#pragma unroll
        for (int j = 0; j < 8; ++j) xo[64 * j] = v[j] * rr * gg[j];
#pragma unroll
        for (int j = 0; j < 8; ++j) v[j] = vn[j];
    }
}

__global__ void __launch_bounds__(NTHR) mixer_fwd(Args args) {
    extern __shared__ __attribute__((aligned(16))) unsigned char lds_raw[];
    Frame F;
    F.lds = (LAS unsigned char*)lds_raw; F.wave = __builtin_amdgcn_readfirstlane(threadIdx.x >> 6); F.tid = 0; F.lane = 0;
    F.G = gridDim.x; F.bid = blockIdx.x; F.out = args.out; F.ws = args.ws;
#pragma unroll
    for (int i = 0; i < 22; ++i) F.in[i] = args.in[i];
    const int lo = args.ph_lo, hi = args.ph_hi;
    { const int t0 = F.wave * 64 + fresh_lane(); if (t0 < 16) ((LAS unsigned*)(F.lds + LDS_BYTES - 64))[t0] = 0u; }
    __syncthreads();
    XcdBarrier bar = xcd_barrier_post((unsigned*)(args.ws + WS_BAR), (volatile LAS unsigned*)(F.lds + LDS_BYTES - 64), F.wave * 64 + fresh_lane());
#ifndef PROBE_DUP
#define PROBE_DUP 0
#endif
#define DUPN(k) ((PROBE_DUP >> (k)) & 1)
#define DUPB(k) for (int rep_ = 0; rep_ <= DUPN(k); ++rep_) {
#define DUPE(k) if (rep_ < DUPN(k)) xcd_barrier(bar, F.wave * 64 + fresh_lane()); }
#define IN(k) (lo <= (k) && (k) < hi)
#define SEAM(k) do { if (IN(k) && IN((k) + 1)) xcd_barrier(bar, F.wave * 64 + fresh_lane()); } while (0)
    unsigned char* ws = args.ws;
    if (IN(0)) { DUPB(0) REFRESH(F); phase_p0(F); __syncthreads(); DUPE(0) } SEAM(0);
    if (IN(1)) {
        DUPB(1)
        pg8::Gemm g{(const pg8::bf16_t*)(ws + WS_XB0), (const pg8::bf16_t*)(ws + WS_WGU1), MT, 2 * DFF, DM}; pg8::StaticOrder S; S.init(MT, 2 * DFF, F.G, F.bid);
        EpiSwiglu E{(bf16*)(ws + WS_ACT), (const float*)(ws + WS_SSQ0)};
        pg8::gemm_phase<EpiSwiglu, pg8::StaticOrder, true, true>(F.lds, g, S, E, F.wave * 64 + fresh_lane());
        REFRESH(F); convert_queue<1>(F, (unsigned*)(ws + WS_QCTR + 64), nullptr);
        DUPE(1)
    } SEAM(1);
    if (IN(2)) {
        DUPB(2)
        pg8::Gemm g{(const pg8::bf16_t*)(ws + WS_ACT), (const pg8::bf16_t*)(ws + WS_WD1), MT, DM, DFF}; SplitOrder S; S.init2(MT, DM, DFF, F.G, F.bid);
        EpiResid E{args.in[I_XP], args.in[I_XS], args.out + O_Y, (bf16*)(ws + WS_X1B), (float*)(ws + WS_SSQ1), 0.5f, (float*)(ws + WS_SLAB)};
        pg8::gemm_phase<EpiResid, SplitOrder, true, true>(F.lds, g, S, E, F.wave * 64 + fresh_lane());
        if (S.split) { xcd_barrier(bar, F.wave * 64 + fresh_lane()); REFRESH(F); resid_fixup(F, S, args.in[I_XP], args.in[I_XS], args.out + O_Y, (bf16*)(ws + WS_X1B), (float*)(ws + WS_SSQ1), 0.5f, (const float*)(ws + WS_SLAB)); }
        DUPE(2)
    } SEAM(2);
    if (IN(3)) {
        DUPB(3)
        pg8::Gemm g{(const pg8::bf16_t*)(ws + WS_X1B), (const pg8::bf16_t*)(ws + WS_WIN), MT, NINP, DM}; pg8::StaticOrder S; S.init(MT, NINP, F.G, F.bid);
        EpiInProj E{(bf16*)(ws + WS_P), (bf16*)(ws + WS_GATES), (float*)(ws + WS_GAGB), (const float*)(ws + WS_SSQ1), args.out + O_CONVP, args.out + O_CONVS};
        pg8::gemm_phase<EpiInProj, pg8::StaticOrder, true, true>(F.lds, g, S, E, F.wave * 64 + fresh_lane());
        DUPE(3)
    } SEAM(3);
#ifndef PROBE_AFLAGS
#define PROBE_AFLAGS -1
#endif
    if (IN(4)) { for (int rep_ = (PROBE_AFLAGS < 0 ? 1 : 0); rep_ < 2; ++rep_) { REFRESH(F); phase_a(F, rep_ == 0 ? (PROBE_AFLAGS & args.ph_hi) : 0); if (rep_ == 0) xcd_barrier(bar, F.wave * 64 + fresh_lane()); } } SEAM(4);
#ifndef PROBE_BFLAGS
#define PROBE_BFLAGS -1
#endif
    if (IN(5)) { for (int rep_ = (PROBE_BFLAGS < 0 ? 1 : 0); rep_ < 2; ++rep_) { REFRESH(F); phase_b(F, rep_ == 0 ? (PROBE_BFLAGS & args.ph_hi) : 0); if (rep_ == 0) xcd_barrier(bar, F.wave * 64 + fresh_lane()); } } SEAM(5);
#ifndef PROBE_CFLAGS
#define PROBE_CFLAGS -1
#endif
    if (IN(6)) { for (int rep_ = (PROBE_CFLAGS < 0 ? 1 : 0); rep_ < 2; ++rep_) { REFRESH(F); phase_c(F, rep_ == 0 ? (PROBE_CFLAGS & args.ph_hi) : 0); if (rep_ == 0) xcd_barrier(bar, F.wave * 64 + fresh_lane()); } } SEAM(6);
    if (IN(7)) {
        pg8::Gemm g{(const pg8::bf16_t*)(ws + WS_O), (const pg8::bf16_t*)(ws + WS_WOUT), MT, DM, DM}; SplitOrder S; S.init2(MT, DM, DM, F.G, F.bid);
        EpiResid E{args.out + O_Y, args.out + O_Y + (size_t)MP * DM, args.out + O_Y, (bf16*)(ws + WS_X2B), (float*)(ws + WS_SSQ2), 1.0f, (float*)(ws + WS_SLAB)};
        pg8::gemm_phase<EpiResid, SplitOrder, true, true>(F.lds, g, S, E, F.wave * 64 + fresh_lane());
        REFRESH(F); convert_queue<0>(F, (unsigned*)(ws + WS_QCTR), nullptr);
        if (S.split) { xcd_barrier(bar, F.wave * 64 + fresh_lane()); REFRESH(F); resid_fixup(F, S, args.out + O_Y, args.out + O_Y + (size_t)MP * DM, args.out + O_Y, (bf16*)(ws + WS_X2B), (float*)(ws + WS_SSQ2), 1.0f, (const float*)(ws + WS_SLAB)); }
    } SEAM(7);
    if (IN(8)) {
        DUPB(8)
        pg8::Gemm g{(const pg8::bf16_t*)(ws + WS_X2B), (const pg8::bf16_t*)(ws + WS_WGU2), MT, 2 * DFF, DM}; pg8::StaticOrder S; S.init(MT, 2 * DFF, F.G, F.bid);
        EpiSwiglu E{(bf16*)(ws + WS_ACT), (const float*)(ws + WS_SSQ2)};
        pg8::gemm_phase<EpiSwiglu, pg8::StaticOrder, true, true>(F.lds, g, S, E, F.wave * 64 + fresh_lane());
        DUPE(8)
    } SEAM(8);
    if (IN(9)) {
        pg8::Gemm g{(const pg8::bf16_t*)(ws + WS_ACT), (const pg8::bf16_t*)(ws + WS_WD2), MT, DM, DFF}; SplitOrder S; S.init2(MT, DM, DFF, F.G, F.bid);
        EpiResid E{args.out + O_Y, args.out + O_Y + (size_t)MP * DM, args.out + O_Y, nullptr, (float*)(ws + WS_SSQ3), 0.5f, (float*)(ws + WS_SLAB)};
        pg8::gemm_phase<EpiResid, SplitOrder, true, true>(F.lds, g, S, E, F.wave * 64 + fresh_lane());
    } SEAM(9);
    if (IN(10)) { REFRESH(F); SplitOrder S; S.init2(MT, DM, DFF, F.G, F.bid); phase_final(F, S); }
#undef IN
#undef SEAM
}

extern "C" void kernel_launch(void* const* d_in, const int* in_sizes, int n_in, void* d_out, int out_size, void* d_ws, size_t ws_size, hipStream_t stream) {
    static int grid = 0;
    if (grid == 0) {
        if (n_in != 22 || (size_t)out_size != O_END || ws_size < WS_END) { fprintf(stderr, "kernel_launch: unexpected shapes: n_in %d out %d (want %zu) ws %zu (need %zu)\n", n_in, out_size, (size_t)O_END, ws_size, (size_t)WS_END); grid = -1; return; }
        int dev = 0, cus = 0, per_cu = 0;
        hipGetDevice(&dev); hipDeviceGetAttribute(&cus, hipDeviceAttributeMultiprocessorCount, dev);
        hipFuncSetAttribute((const void*)mixer_fwd, hipFuncAttributeMaxDynamicSharedMemorySize, LDS_BYTES);
        hipOccupancyMaxActiveBlocksPerMultiprocessor(&per_cu, (const void*)mixer_fwd, NTHR, LDS_BYTES);
        if (per_cu < 1) { fprintf(stderr, "kernel_launch: occupancy query says %d blocks/CU\n", per_cu); grid = -1; return; }
        grid = cus;
    }
    if (grid < 0) return;
    Args a{};
    for (int i = 0; i < 22; ++i) a.in[i] = (const float*)d_in[i];
    a.out = (float*)d_out; a.ws = (unsigned char*)d_ws; a.ph_lo = 0; a.ph_hi = 11;
    if (hipMemsetAsync((char*)d_ws + WS_BAR, 0, 16384 + 256, stream) != hipSuccess) { fprintf(stderr, "kernel_launch: memset failed\n"); return; }
    hipLaunchKernelGGL(mixer_fwd, dim3(grid), dim3(NTHR), LDS_BYTES, stream, a);
    hipError_t e = hipPeekAtLastError();
    if (e != hipSuccess) fprintf(stderr, "launch failed: %s (grid %d)\n", hipGetErrorString(e), grid);
}
```
